# Optimizing an MI355X kernel written in HIP

```python
import jax, jax.numpy as jnp
from jax import lax
import numpy as np

D_MODEL = 2048
BATCH = 4
SEQ = 2048
DEPTH = 2

CHUNK = 64
Q_BLOCK = 128
MIX_WIDTH = D_MODEL
EPS = 1e-6
MLA_HEADS = 8
MLA_Q_LORA = 512
MLA_KV_LORA = 256
MLA_NOPE = 128
MLA_ROPE = 64
MLA_V = 128
ROPE_BASE = 10000.0
SB_HEADS = 8
SB_DIM = 64
FOX_HEADS = 8
FOX_DIM = 64
IN_SIZES = (MLA_Q_LORA, MLA_KV_LORA, MLA_ROPE, 3 * SB_HEADS * SB_DIM, 3 * FOX_HEADS * FOX_DIM, FOX_HEADS)
IN_WIDTH = MLA_Q_LORA + MLA_KV_LORA + MLA_ROPE + 3 * SB_HEADS * SB_DIM + 3 * FOX_HEADS * FOX_DIM + FOX_HEADS
OUT_SIZES = (MLA_HEADS * MLA_V, SB_HEADS * SB_DIM, FOX_HEADS * FOX_DIM)
D_FF = 4 * D_MODEL

kernel_name = 'hybrid_mla_stickbreak_fox_block'


def rms_norm(x, g):
    xf = x.astype(jnp.float32)
    y = xf * lax.rsqrt(jnp.mean(xf * xf, axis=-1, keepdims=True) + EPS)
    return (y * g.astype(jnp.float32)).astype(x.dtype)


def split_sizes(p, sizes):
    idx, acc = [], 0
    for s in sizes[:-1]:
        acc += s
        idx.append(acc)
    return jnp.split(p, idx, axis=-1)


def rope_tables(seq_len, dim):
    pos = jnp.arange(seq_len, dtype=jnp.float32)
    inv = ROPE_BASE ** (-jnp.arange(0, dim, 2, dtype=jnp.float32) / dim)
    ang = pos[:, None] * inv[None, :]
    return jnp.cos(ang), jnp.sin(ang)


def apply_rope(x, cos, sin):
    x1, x2 = jnp.split(x.astype(jnp.float32), 2, axis=-1)
    return jnp.concatenate([x1 * cos - x2 * sin, x2 * cos + x1 * sin], axis=-1).astype(x.dtype)


def head_rms_norm(o, g):
    B, S, H, d = o.shape
    return rms_norm(o, g.reshape(H, d)).reshape(B, S, H * d)


def mla_attention(q_nope, q_rope, k_nope, k_rope, v):
    S = q_nope.shape[1]
    scale = (MLA_NOPE + MLA_ROPE) ** -0.5
    outs = []
    for i in range(S // Q_BLOCK):
        q0, q1 = i * Q_BLOCK, (i + 1) * Q_BLOCK
        s = (jnp.einsum('bqhd,bkhd->bhqk', q_nope[:, q0:q1], k_nope[:, :q1])
             + jnp.einsum('bqhd,bkd->bhqk', q_rope[:, q0:q1], k_rope[:, :q1])).astype(jnp.float32) * scale
        t_pos = jnp.arange(q0, q1)[:, None]
        s_pos = jnp.arange(q1)[None, :]
        allowed = s_pos < (t_pos // CHUNK + 1) * CHUNK
        p = jax.nn.softmax(jnp.where(allowed, s, -jnp.inf), axis=-1)
        outs.append(jnp.einsum('bhqk,bkhd->bqhd', p.astype(v.dtype), v[:, :q1]))
    return jnp.concatenate(outs, axis=1)


def stick_breaking_attention(q, k, v):
    S, d = q.shape[1], q.shape[3]
    scale = d ** -0.5
    outs = []
    for i in range(S // Q_BLOCK):
        q0, q1 = i * Q_BLOCK, (i + 1) * Q_BLOCK
        z = jnp.einsum('bqhd,bkhd->bhqk', q[:, q0:q1], k[:, :q1]).astype(jnp.float32) * scale
        t_pos = jnp.arange(q0, q1)[:, None]
        s_pos = jnp.arange(q1)[None, :]
        strict = s_pos < t_pos
        log_keep = jnp.where(strict, jax.nn.log_sigmoid(-z), 0.0)
        log_stick = lax.cumsum(log_keep, axis=3, reverse=True) - log_keep
        a = jnp.where(strict, jnp.exp(jax.nn.log_sigmoid(z) + log_stick), 0.0)
        outs.append(jnp.einsum('bhqk,bkhd->bqhd', a.astype(v.dtype), v[:, :q1]))
    return jnp.concatenate(outs, axis=1)


def forgetting_attention(q, k, v, log_f):
    S, d = q.shape[1], q.shape[3]
    scale = d ** -0.5
    F = jnp.swapaxes(jnp.cumsum(log_f, axis=1), 1, 2)
    outs = []
    for i in range(S // Q_BLOCK):
        q0, q1 = i * Q_BLOCK, (i + 1) * Q_BLOCK
        s = jnp.einsum('bqhd,bkhd->bhqk', q[:, q0:q1], k[:, :q1]).astype(jnp.float32) * scale
        s = s + F[:, :, q0:q1, None] - F[:, :, None, :q1]
        t_pos = jnp.arange(q0, q1)[:, None]
        s_pos = jnp.arange(q1)[None, :]
        p = jax.nn.softmax(jnp.where(s_pos <= t_pos, s, -jnp.inf), axis=-1)
        outs.append(jnp.einsum('bhqk,bkhd->bqhd', p.astype(v.dtype), v[:, :q1]))
    return jnp.concatenate(outs, axis=1)


def setup_inputs(seed: int = 0) -> dict:
    key = jax.random.key(seed)
    ks = jax.random.split(key, 20)
    n = jax.random.normal
    f32 = jnp.float32
    L, D = DEPTH, D_MODEL
    return {
        'x': n(ks[0], (BATCH, SEQ, D), f32),
        'c': n(ks[1], (BATCH, D), f32),
        'w_ada': n(ks[2], (L, D, 6 * D), f32) * (0.5 * D ** -0.5),
        'b_ada': n(ks[3], (L, 6 * D), f32) * 0.01,
        'norm_mix': 1.0 + 0.02 * n(ks[4], (L, D), f32),
        'w_in': n(ks[5], (L, D, IN_WIDTH), f32) * D ** -0.5,
        'q_norm': 1.0 + 0.02 * n(ks[6], (L, MLA_Q_LORA), f32),
        'w_uq': n(ks[7], (L, MLA_Q_LORA, MLA_HEADS * (MLA_NOPE + MLA_ROPE)), f32) * MLA_Q_LORA ** -0.5,
        'kv_norm': 1.0 + 0.02 * n(ks[8], (L, MLA_KV_LORA), f32),
        'w_ukv': n(ks[9], (L, MLA_KV_LORA, MLA_HEADS * (MLA_NOPE + MLA_V)), f32) * MLA_KV_LORA ** -0.5,
        'b_forget': 0.1 * n(ks[10], (L, FOX_HEADS), f32),
        'out_norm': 1.0 + 0.02 * n(ks[11], (L, MIX_WIDTH), f32),
        'w_out': n(ks[12], (L, MIX_WIDTH, D), f32) * MIX_WIDTH ** -0.5,
        'norm_ffn': 1.0 + 0.02 * n(ks[13], (L, D), f32),
        'w_ff1': n(ks[14], (L, D, D_FF), f32) * D ** -0.5,
        'w_ff2': n(ks[15], (L, D_FF, D), f32) * D_FF ** -0.5,
        'final_norm': 1.0 + 0.02 * n(ks[16], (D,), f32),
    }


def reference(x, c, w_ada, b_ada, norm_mix, w_in, q_norm, w_uq, kv_norm, w_ukv, b_forget,
              out_norm, w_out, norm_ffn, w_ff1, w_ff2, final_norm):
    B, S, _ = x.shape
    cos, sin = rope_tables(S, MLA_ROPE)
    c_act = jax.nn.silu(c)
    for l in range(DEPTH):
        mod = c_act @ w_ada[l] + b_ada[l]
        sh_a, sc_a, g_a, sh_m, sc_m, g_m = [m[:, None, :] for m in jnp.split(mod, 6, axis=-1)]

        h = rms_norm(x, norm_mix[l]) * (1.0 + sc_a) + sh_a
        p = h @ w_in[l]
        p_cq, p_ckv, p_kr, p_sb, p_fox, p_f = split_sizes(p, IN_SIZES)

        q = (rms_norm(p_cq, q_norm[l]) @ w_uq[l]).reshape(B, S, MLA_HEADS, MLA_NOPE + MLA_ROPE)
        kv = (rms_norm(p_ckv, kv_norm[l]) @ w_ukv[l]).reshape(B, S, MLA_HEADS, MLA_NOPE + MLA_V)
        q_nope = q[..., :MLA_NOPE]
        q_rope = apply_rope(q[..., MLA_NOPE:], cos[None, :, None, :], sin[None, :, None, :])
        k_nope, v_mla = kv[..., :MLA_NOPE], kv[..., MLA_NOPE:]
        k_rope = apply_rope(p_kr, cos[None], sin[None])
        o_mla = mla_attention(q_nope, q_rope, k_nope, k_rope, v_mla)

        q_sb, k_sb, v_sb = [t.reshape(B, S, SB_HEADS, SB_DIM) for t in jnp.split(p_sb, 3, axis=-1)]
        o_sb = stick_breaking_attention(q_sb, k_sb, v_sb)

        q_fx, k_fx, v_fx = [t.reshape(B, S, FOX_HEADS, FOX_DIM) for t in jnp.split(p_fox, 3, axis=-1)]
        log_f = jax.nn.log_sigmoid((p_f + b_forget[l]).astype(jnp.float32))
        o_fx = forgetting_attention(q_fx, k_fx, v_fx, log_f)

        g_mla, g_sb, g_fx = split_sizes(out_norm[l], OUT_SIZES)
        o = jnp.concatenate([head_rms_norm(o_mla, g_mla), head_rms_norm(o_sb, g_sb),
                             head_rms_norm(o_fx, g_fx)], axis=-1)
        x = x + g_a * (o @ w_out[l])

        h = rms_norm(x, norm_ffn[l]) * (1.0 + sc_m) + sh_m
        x = x + g_m * (jnp.square(jax.nn.relu(h @ w_ff1[l])) @ w_ff2[l])
    return rms_norm(x, final_norm)
```

```cpp
#include <hip/hip_runtime.h>
#include <hip/hip_cooperative_groups.h>
#include <cstdio>
#include <cstdint>
namespace cg = cooperative_groups;

#ifndef MK_MULTI
#define MK_MULTI 0
#endif

#define LAS __attribute__((address_space(3)))
typedef unsigned short bf16_t;
typedef short bf16x8 __attribute__((ext_vector_type(8)));
typedef float f32x2 __attribute__((ext_vector_type(2)));
typedef float f32x4 __attribute__((ext_vector_type(4)));
typedef float f32x16 __attribute__((ext_vector_type(16)));
typedef unsigned u32x2 __attribute__((ext_vector_type(2)));
typedef unsigned u32x4 __attribute__((ext_vector_type(4)));

constexpr int DM = 2048, SEQ = 2048, MTOK = 8192, DFF = 8192, INW = 3912, ADAW = 12288;
constexpr float EPS = 1e-6f;
constexpr float LOG2E = 1.4426950408889634f;
constexpr float QSCALE64 = 0.125f * LOG2E;
constexpr float QSCALE192 = 0.07216878364870323f * LOG2E;

constexpr size_t MiB = 1u << 20;
constexpr size_t WS_CTL = 0, CTL_BYTES = 65536;
constexpr size_t WS_XCH = 5 * MiB;
constexpr size_t WS_ROPE = 1 * MiB;
constexpr size_t WS_MOD = 2 * MiB;
constexpr size_t WS_SSQQ = 3 * MiB;
constexpr size_t WS_SSQKV = 3 * MiB + 512 * 1024;
constexpr size_t WS_NF2 = 4 * MiB;
constexpr size_t WS_LOGF = 4 * MiB + 512 * 1024;
constexpr size_t WS_WIN = 8 * MiB;
constexpr size_t WS_WINV = 32 * MiB;
constexpr size_t WS_WUQ = 40 * MiB;
constexpr size_t WS_WUKVK = 43 * MiB;
constexpr size_t WS_WUKVV = 44 * MiB;
constexpr size_t WS_WOUT = 48 * MiB;
constexpr size_t WS_W1 = 64 * MiB;
constexpr size_t WS_W2 = 128 * MiB;
constexpr size_t WS_H = 192 * MiB;
constexpr size_t WS_CQ = 224 * MiB;
constexpr size_t WS_CKV = 232 * MiB;
constexpr size_t WS_KR = 236 * MiB;
constexpr size_t WS_QK4 = 240 * MiB;
constexpr size_t WS_VTS = 272 * MiB;
constexpr size_t WS_QM = 288 * MiB;
constexpr size_t WS_KN = 312 * MiB;
constexpr size_t WS_VTM = 328 * MiB;
constexpr size_t WS_OB = 344 * MiB;
constexpr size_t WS_X = 384 * MiB;
constexpr size_t WS_HB = 448 * MiB;
constexpr size_t WS_END = 576 * MiB;

constexpr int LDS_BYTES = 135168;
constexpr int MISC_OFF = 131072;

__device__ const float INVF[32] = {1.0f, 0.7498942613601685f, 0.5623413324356079f, 0.4216965138912201f, 0.3162277638912201f, 0.23713737726211548f, 0.17782793939113617f, 0.133352130651474f, 0.10000000149011612f, 0.07498941570520401f, 0.05623413249850273f, 0.04216965287923813f, 0.03162277489900589f, 0.023713737726211548f, 0.017782794311642647f, 0.01333521492779255f, 0.009999999776482582f, 0.007498941849917173f, 0.005623413249850273f, 0.0042169648222625256f, 0.003162277629598975f, 0.00237137358635664f, 0.0017782794311642647f, 0.0013335214462131262f, 0.0010000000474974513f, 0.0007498942431993783f, 0.000562341301701963f, 0.0004216965171508491f, 0.0003162277571391314f, 0.00023713737027719617f, 0.00017782794020604342f, 0.0001333521504420787f};
__device__ const unsigned char ATT_ORDER[24] = {7, 6, 15, 5, 14, 23, 4, 13, 22, 3, 12, 21, 11, 20, 2, 19, 10, 1, 18, 9, 17, 0, 8, 16};
__device__ __forceinline__ int att_code(int grp) {
    const unsigned long long w = (grp < 12) ? 0xab076692ee2bcc7ull : 0x820114c82a98a8bull;
    return (int)((w >> (5 * ((grp < 12) ? grp : grp - 12))) & 31ull);
}

typedef __bf16 bf16x2_t __attribute__((ext_vector_type(2)));
__device__ __forceinline__ unsigned cvt_pk_bf16(float lo, float hi) { const f32x2 v = {lo, hi}; const bf16x2_t b = __builtin_convertvector(v, bf16x2_t); return __builtin_bit_cast(unsigned, b); }
__device__ __forceinline__ float shx(float v, int lane, int o) { return __builtin_bit_cast(float, __builtin_amdgcn_ds_bpermute((lane ^ o) << 2, __builtin_bit_cast(int, v))); }
__device__ __forceinline__ float wave_sum(float v, int lane) {
#pragma unroll
    for (int o = 1; o < 64; o <<= 1) v += shx(v, lane, o);
    return v;
}
__device__ __forceinline__ int opaque_tid(int wv) { unsigned z = 0u; asm volatile("" : "+v"(z)); return (wv << 6) | (int)__builtin_amdgcn_mbcnt_hi(~0u, __builtin_amdgcn_mbcnt_lo(~0u, z)); }
__device__ __forceinline__ float fexp2(float x) { return __builtin_amdgcn_exp2f(x); }
__device__ __forceinline__ float flog2(float x) { return __builtin_amdgcn_logf(x); }

namespace pg8 {
constexpr int BM = 256, BK = 64, HALF = 128, HTB = HALF * BK * 2, STAGE_BYTES = 8 * HTB, NXCD = 8, WGM = 4;
__host__ __device__ __forceinline__ int lds_byte(int r, int c) { const int st = (r >> 4) * 2 + (c >> 5), rr = r & 15, cc = c & 31, ob = rr * 64 + cc * 2; return st * 1024 + (ob ^ (((ob >> 9) & 1) << 5)); }
__host__ __device__ __forceinline__ void stage_rc(int b, int& R, int& C) { const int st = b / 1024, sb = b % 1024, swz = sb ^ (((sb >> 9) & 1) << 5); R = (st >> 1) * 16 + swz / 64; C = (st & 1) * 32 + (swz % 64) / 2; }
__host__ __device__ __forceinline__ int perm32(int rho) { const int n = rho >> 4, i = rho & 15; return 8 * (i >> 2) + 4 * n + (i & 3); }
struct Unit { int pm, pn, g; };
struct Gemm { const bf16_t* A; const bf16_t* Bt; int M, N, K; };
struct StaticOrder {
    int nM, nN, nwg, G, c;
    __device__ __forceinline__ void init(int M, int N, int G_, int c_) { nM = M / BM; nN = N / BM; nwg = nM * nN; G = G_; c = c_; }
    __device__ __forceinline__ bool next(int i, Unit& u) const {
        const long L = (long)i * G + c; if (L >= nwg) return false;
        int wgid = (int)L; { const int q = nwg / NXCD, r = nwg % NXCD, xcd = wgid % NXCD, off = wgid / NXCD; wgid = (xcd < r ? xcd * (q + 1) : r * (q + 1) + (xcd - r) * q) + off; }
        const int nig = WGM * nN, gid = wgid / nig, fm = gid * WGM, gsz = (nM - fm) < WGM ? (nM - fm) : WGM;
        u.pm = fm + ((wgid % nig) % gsz); u.pn = (wgid % nig) / gsz; u.g = 0; return true;
    }
};
template <class Epi, class Sched>
__device__ __forceinline__ void gemm_phase(LAS unsigned char* lds, const Gemm g, const Sched& S, const Epi& E, const int wv, const Gemm g2) {
    const int tid = opaque_tid(wv), wid = __builtin_amdgcn_readfirstlane(tid >> 6), lane = tid & 63, wr = wid >> 2, wc = wid & 3, fr = lane & 15, fq = lane >> 4;
    const int K = g.K, nt = K / BK;
    unsigned voffA[2], voffB[2];
#pragma unroll
    for (int i = 0; i < 2; ++i) { int R, C; stage_rc(tid * 16 + i * 8192, R, C); const int Rb = Epi::PERM ? ((R & ~31) + perm32(R & 31)) : R;
        voffA[i] = (unsigned)(R * K + C) * 2u; voffB[i] = (unsigned)(Rb * K + C) * 2u; }
    const size_t kstep = (size_t)(BK * 2);
    const size_t hstep = (size_t)HALF * K * 2;
    const size_t tstep = 2 * hstep;
    const unsigned ldsw = (unsigned)wid * 1024u;
    const int aoff = lds_byte(wr * 64 + fr, fq * 8), boff = lds_byte(wc * 32 + fr, fq * 8);
#define PG8_SA(b, h) (((b) * 2 + (h)) * HTB)
#define PG8_SB(b, h) ((4 + (b) * 2 + (h)) * HTB)
#define PG8_STAGE(bufoff, gbase, voff) do { _Pragma("unroll") for (int _i = 0; _i < 2; ++_i) \
        __builtin_amdgcn_global_load_lds((const unsigned*)((const char*)(gbase) + (voff)[_i]), (LAS unsigned*)(lds + (bufoff) + ldsw + _i * 8192), 16, 0, 0); } while (0)
#define PG8_LDA(dst, b, h) do { _Pragma("unroll") for (int m = 0; m < 4; ++m) _Pragma("unroll") for (int k = 0; k < 2; ++k) dst[m][k] = *(const LAS bf16x8*)(lds + PG8_SA(b, h) + aoff + m * 2048 + k * 1024); } while (0)
#define PG8_LDB(dst, b, h) do { _Pragma("unroll") for (int n = 0; n < 2; ++n) _Pragma("unroll") for (int k = 0; k < 2; ++k) dst[n][k] = *(const LAS bf16x8*)(lds + PG8_SB(b, h) + boff + n * 2048 + k * 1024); } while (0)
#define PG8_MMA(ai, bj, At, Bt) do { __builtin_amdgcn_s_setprio(1); _Pragma("unroll") for (int m = 0; m < 4; ++m) _Pragma("unroll") for (int n = 0; n < 2; ++n) _Pragma("unroll") for (int k = 0; k < 2; ++k) \
        acc[ai][bj][m][n] = __builtin_amdgcn_mfma_f32_16x16x32_bf16(Bt[n][k], At[m][k], acc[ai][bj][m][n], 0, 0, 0); __builtin_amdgcn_s_setprio(0); } while (0)
#define PG8_WAIT_V(n) asm volatile("s_waitcnt vmcnt(" #n ")" ::: "memory")
#define PG8_WAIT_L(n) asm volatile("s_waitcnt lgkmcnt(" #n ")" ::: "memory")
#define PG8_BAR __builtin_amdgcn_s_barrier()
#define PG8_SCHED __builtin_amdgcn_sched_barrier(0)
    Unit cur, nxt; int ui = 0;
    if (!S.next(0, cur)) return;
    f32x4 acc[2][2][4][2];
#pragma unroll
    for (int a = 0; a < 2; ++a)
#pragma unroll
        for (int b = 0; b < 2; ++b)
#pragma unroll
            for (int m = 0; m < 4; ++m)
#pragma unroll
                for (int n = 0; n < 2; ++n) acc[a][b][m][n] = (f32x4){0.f, 0.f, 0.f, 0.f};
    bf16x8 At[4][2], B0[2][2], B1[2][2];
    const char* cA = (const char*)(cur.g ? g2.A : g.A) + (size_t)cur.pm * tstep; const char* cB = (const char*)(cur.g ? g2.Bt : g.Bt) + (size_t)cur.pn * tstep;
    PG8_STAGE(PG8_SB(0, 0), cB, voffB); PG8_STAGE(PG8_SB(0, 1), cB + hstep, voffB); PG8_STAGE(PG8_SA(0, 0), cA, voffA); PG8_STAGE(PG8_SA(0, 1), cA + hstep, voffA);
    if (wr == 1) PG8_BAR;
    PG8_WAIT_V(2); PG8_BAR;
    PG8_STAGE(PG8_SB(1, 0), cB + kstep, voffB); PG8_STAGE(PG8_SA(1, 0), cA + kstep, voffA); PG8_STAGE(PG8_SB(1, 1), cB + hstep + kstep, voffB);
    PG8_WAIT_V(6); PG8_BAR;
    for (;;) {
        const bool has_next = S.next(ui + 1, nxt);
        const char* nA = has_next ? (const char*)(nxt.g ? g2.A : g.A) + (size_t)nxt.pm * tstep : cA; const char* nB = has_next ? (const char*)(nxt.g ? g2.Bt : g.Bt) + (size_t)nxt.pn * tstep : cB;
        for (int t = 0; t < nt; t += 2) {
            const bool last = (t == nt - 2);
            const char* a1 = cA + (size_t)(t + 1) * kstep;
            const char* a2 = last ? nA : cA + (size_t)(t + 2) * kstep; const char* b2 = last ? nB : cB + (size_t)(t + 2) * kstep;
            const char* a3 = a2 + kstep; const char* b3 = b2 + kstep;
            PG8_LDB(B0, 0, 0); PG8_LDB(B1, 0, 1); PG8_SCHED; PG8_LDA(At, 0, 0); PG8_STAGE(PG8_SA(1, 1), a1 + hstep, voffA);
            PG8_WAIT_V(8); PG8_WAIT_L(0); PG8_BAR; PG8_MMA(0, 0, At, B0); PG8_MMA(0, 1, At, B1); PG8_BAR; PG8_SCHED;
            PG8_LDA(At, 0, 1); PG8_STAGE(PG8_SB(0, 0), b2, voffB); PG8_STAGE(PG8_SB(0, 1), b2 + hstep, voffB); PG8_STAGE(PG8_SA(0, 0), a2, voffA);
            PG8_WAIT_V(8); PG8_WAIT_L(0); PG8_BAR; PG8_MMA(1, 0, At, B0); PG8_MMA(1, 1, At, B1); PG8_BAR; PG8_SCHED;
            PG8_LDB(B0, 1, 0); PG8_LDB(B1, 1, 1); PG8_SCHED; PG8_LDA(At, 1, 0); PG8_STAGE(PG8_SA(0, 1), a2 + hstep, voffA);
            PG8_WAIT_V(8); PG8_WAIT_L(0); PG8_BAR; PG8_MMA(0, 0, At, B0); PG8_MMA(0, 1, At, B1); PG8_BAR; PG8_SCHED;
            PG8_LDA(At, 1, 1); PG8_STAGE(PG8_SB(1, 0), b3, voffB); PG8_STAGE(PG8_SB(1, 1), b3 + hstep, voffB); PG8_STAGE(PG8_SA(1, 0), a3, voffA);
            PG8_WAIT_V(8); PG8_WAIT_L(0); PG8_BAR; PG8_MMA(1, 0, At, B0); PG8_MMA(1, 1, At, B1); PG8_BAR; PG8_SCHED;
        }
        if (wr == 0) PG8_BAR;
        if constexpr (!Epi::AFTER_DRAIN) { const int t2_ = opaque_tid(wv), w2_ = __builtin_amdgcn_readfirstlane(t2_ >> 6), l2_ = t2_ & 63; E(acc, cur, w2_ >> 2, w2_ & 3, l2_ & 15, l2_ >> 4); }
        if (!has_next) break;
#pragma unroll
        for (int a = 0; a < 2; ++a)
#pragma unroll
            for (int b = 0; b < 2; ++b)
#pragma unroll
                for (int m = 0; m < 4; ++m)
#pragma unroll
                    for (int n = 0; n < 2; ++n) acc[a][b][m][n] = (f32x4){0.f, 0.f, 0.f, 0.f};
        cur = nxt; cA = nA; cB = nB; ++ui;
        if (wr == 1) PG8_BAR;
    }
    PG8_WAIT_V(0);
    PG8_BAR;
    if constexpr (Epi::AFTER_DRAIN) { const int t2_ = opaque_tid(wv), w2_ = __builtin_amdgcn_readfirstlane(t2_ >> 6), l2_ = t2_ & 63; E.fused(acc, cur, w2_ >> 2, w2_ & 3, l2_ & 15, l2_ >> 4, lds, w2_, l2_); }
#undef PG8_SA
#undef PG8_SB
#undef PG8_STAGE
#undef PG8_LDA
#undef PG8_LDB
#undef PG8_MMA
#undef PG8_WAIT_V
#undef PG8_WAIT_L
#undef PG8_BAR
#undef PG8_SCHED
}
template <class Epi, class Sched>
__device__ __forceinline__ void gemm_phase(LAS unsigned char* lds, const Gemm g, const Sched& S, const Epi& E, const int wv) { gemm_phase(lds, g, S, E, wv, g); }
struct TwoOrders {
    StaticOrder s0, s1; int n0;
    __device__ __forceinline__ void init(int M0, int N0, int c0, int M1, int N1, int c1, int G) { s0.init(M0, N0, G, c0); s1.init(M1, N1, G, c1); n0 = (c0 < s0.nwg) ? (s0.nwg - c0 + G - 1) / G : 0; }
    __device__ __forceinline__ bool next(int i, Unit& u) const {
        if (i < n0) { (void)s0.next(i, u); u.g = 0; return true; }
        if (s1.next(i - n0, u)) { u.g = 1; return true; }
        return false;
    }
};
}
using pg8::Unit;

__device__ __forceinline__ void store8(bf16_t* p, const f32x4 v0, const f32x4 v1) {
    u32x4 w; w.x = cvt_pk_bf16(v0[0], v0[1]); w.y = cvt_pk_bf16(v0[2], v0[3]); w.z = cvt_pk_bf16(v1[0], v1[1]); w.w = cvt_pk_bf16(v1[2], v1[3]);
    *(u32x4*)p = w;
}
__device__ __forceinline__ void store8_perm16(bf16_t* rowp, int c0, const f32x4 v0, const f32x4 v1) {
    const int p0 = (c0 & ~15) + ((c0 & 15) >> 1);
    u32x2 a, b; a.x = cvt_pk_bf16(v0[0], v0[1]); a.y = cvt_pk_bf16(v0[2], v0[3]); b.x = cvt_pk_bf16(v1[0], v1[1]); b.y = cvt_pk_bf16(v1[2], v1[3]);
    *(u32x2*)(rowp + p0) = a; *(u32x2*)(rowp + p0 + 8) = b;
}
__device__ __forceinline__ void rope8(f32x4& v0, f32x4& v1, const f32x2* rope, int pos, int i0) {
    const f32x4 a = *(const f32x4*)(rope + pos * 32 + i0), b = *(const f32x4*)(rope + pos * 32 + i0 + 2);
    f32x4 o0, o1;
    o0[0] = v0[0] * a[0] - v0[1] * a[1]; o0[1] = v0[1] * a[0] + v0[0] * a[1];
    o0[2] = v0[2] * a[2] - v0[3] * a[3]; o0[3] = v0[3] * a[2] + v0[2] * a[3];
    o1[0] = v1[0] * b[0] - v1[1] * b[1]; o1[1] = v1[1] * b[0] + v1[0] * b[1];
    o1[2] = v1[2] * b[2] - v1[3] * b[3]; o1[3] = v1[3] * b[2] + v1[2] * b[3];
    v0 = o0; v1 = o1;
}
__device__ __forceinline__ float log_sigmoid_f(float x) { return fminf(x, 0.f) - 0.6931471805599453f * flog2(1.0f + fexp2(-1.4426950408889634f * fabsf(x))); }

struct EpiIn {
    static constexpr bool PERM = true, AFTER_DRAIN = false;
    bf16_t *CQ, *CKV, *KR, *QK4; float *SSQQ, *SSQKV, *LOGF; const f32x2* rope; const float* bforget;
    __device__ __forceinline__ void operator()(const f32x4 (&acc)[2][2][4][2], const Unit& u, int wr, int wc, int fr, int fq) const {
        const int pn = u.pn, row0 = u.pm * 256 + wr * 64 + fr;
        if (pn < 11) {
            bf16_t* base; int ld, col0; float sc = 1.f; float* ssq = nullptr;
            if (pn < 2) { base = CQ; ld = 512; col0 = pn * 256; ssq = SSQQ + (size_t)(pn * 4 + wc) * MTOK; }
            else if (pn == 2) { base = CKV; ld = 256; col0 = 0; ssq = SSQKV + (size_t)wc * MTOK; }
            else { const int t = pn - 3; base = QK4 + (size_t)(t >> 1) * ((size_t)MTOK * 512); ld = 512; col0 = (t & 1) * 256; if (((t >> 1) & 1) == 0) sc = QSCALE64; }
            col0 += wc * 32 + 8 * fq;
#pragma unroll
            for (int ai = 0; ai < 2; ++ai)
#pragma unroll
                for (int m = 0; m < 4; ++m) {
                    const int row = row0 + ai * 128 + m * 16; float s = 0.f;
#pragma unroll
                    for (int bj = 0; bj < 2; ++bj) {
                        const f32x4 v0 = acc[ai][bj][m][0] * sc, v1 = acc[ai][bj][m][1] * sc;
                        s += (v0[0] * v0[0] + v0[1] * v0[1]) + (v0[2] * v0[2] + v0[3] * v0[3]) + (v1[0] * v1[0] + v1[1] * v1[1]) + (v1[2] * v1[2] + v1[3] * v1[3]);
                        store8(base + (size_t)row * ld + col0 + bj * 128, v0, v1);
                    }
                    if (ssq) { const int ln_ = fr + 16 * fq; s += shx(s, ln_, 16); s += shx(s, ln_, 32); if (fq == 0) ssq[row] = s; }
                }
        } else {
            const int cl0 = wc * 32 + 8 * fq;
            if (wc < 2) {
#pragma unroll
                for (int ai = 0; ai < 2; ++ai)
#pragma unroll
                    for (int m = 0; m < 4; ++m) {
                        const int row = row0 + ai * 128 + m * 16;
                        f32x4 v0 = acc[ai][0][m][0], v1 = acc[ai][0][m][1];
                        rope8(v0, v1, rope, row & (SEQ - 1), cl0 >> 1);
                        store8(KR + (size_t)row * 64 + cl0, v0, v1);
                        asm volatile("" ::: "memory");
                    }
            } else if (wc == 2 && fq == 0) {
                const f32x4 b0 = *(const f32x4*)(bforget), b1 = *(const f32x4*)(bforget + 4);
#pragma unroll
                for (int ai = 0; ai < 2; ++ai)
#pragma unroll
                    for (int m = 0; m < 4; ++m) {
                        const int row = row0 + ai * 128 + m * 16;
                        const f32x4 x0 = acc[ai][0][m][0] + b0, x1 = acc[ai][0][m][1] + b1; f32x4 l0, l1;
#pragma unroll
                        for (int c = 0; c < 4; ++c) { l0[c] = log_sigmoid_f(x0[c]); l1[c] = log_sigmoid_f(x1[c]); }
                        *(f32x4*)(LOGF + (size_t)row * 8) = l0; *(f32x4*)(LOGF + (size_t)row * 8 + 4) = l1;
                    }
            }
        }
    }
};
struct EpiPlain {
    static constexpr bool PERM = true, AFTER_DRAIN = false;
    bf16_t* O; int ld; int relu2; int perm16;
    __device__ __forceinline__ void operator()(const f32x4 (&acc)[2][2][4][2], const Unit& u, int wr, int wc, int fr, int fq) const {
        const int row0 = u.pm * 256 + wr * 64 + fr, col0 = u.pn * 256 + wc * 32 + 8 * fq;
#pragma unroll
        for (int ai = 0; ai < 2; ++ai)
#pragma unroll
            for (int m = 0; m < 4; ++m) {
                bf16_t* rowp = O + (size_t)(row0 + ai * 128 + m * 16) * ld + col0;
#pragma unroll
                for (int bj = 0; bj < 2; ++bj) {
                    f32x4 v0 = acc[ai][bj][m][0], v1 = acc[ai][bj][m][1];
                    if (relu2) {
#pragma unroll
                        for (int c = 0; c < 4; ++c) { const float a = fmaxf(v0[c], 0.f), b = fmaxf(v1[c], 0.f); v0[c] = a * a; v1[c] = b * b; }
                    }
                    if (perm16) store8_perm16(rowp - col0, col0 + bj * 128, v0, v1); else store8(rowp + bj * 128, v0, v1);
                }
            }
    }
};
struct EpiInBoth {
    static constexpr bool PERM = true, AFTER_DRAIN = false;
    EpiIn e0; EpiPlain e1;
    __device__ __forceinline__ void operator()(const f32x4 (&acc)[2][2][4][2], const Unit& u, int wr, int wc, int fr, int fq) const {
        if (u.g == 0) e0(acc, u, wr, wc, fr, fq); else e1(acc, u, wr, wc, fr, fq);
    }
};
struct EpiUq {
    static constexpr bool PERM = true, AFTER_DRAIN = false;
    bf16_t* QM; const float* SSQQ; const f32x2* rope;
    __device__ __forceinline__ void operator()(const f32x4 (&acc)[2][2][4][2], const Unit& u, int wr, int wc, int fr, int fq) const {
        const int row0 = u.pm * 256 + wr * 64 + fr, col0 = u.pn * 256 + wc * 32 + 8 * fq;
        float fs[2][4];
#pragma unroll
        for (int ai = 0; ai < 2; ++ai)
#pragma unroll
            for (int m = 0; m < 4; ++m) {
                const int row = row0 + ai * 128 + m * 16; float s = 0.f;
#pragma unroll
                for (int k = 0; k < 8; ++k) s += SSQQ[(size_t)k * MTOK + row];
                fs[ai][m] = QSCALE192 / sqrtf(s * (1.0f / 512.0f) + EPS);
            }
#pragma unroll
        for (int ai = 0; ai < 2; ++ai)
#pragma unroll
            for (int m = 0; m < 4; ++m) {
                const int row = row0 + ai * 128 + m * 16;
                const float f = fs[ai][m];
#pragma unroll
                for (int bj = 0; bj < 2; ++bj) {
                    const int c = col0 + bj * 128, w = c % 192;
                    f32x4 v0 = acc[ai][bj][m][0] * f, v1 = acc[ai][bj][m][1] * f;
                    if (w >= 128) rope8(v0, v1, rope, row & (SEQ - 1), (w - 128) >> 1);
                    store8(QM + (size_t)row * 1536 + c, v0, v1);
                }
                asm volatile("" ::: "memory");
            }
    }
};
struct EpiKn {
    static constexpr bool PERM = true, AFTER_DRAIN = false;
    bf16_t* KN; const float* SSQKV;
    __device__ __forceinline__ void operator()(const f32x4 (&acc)[2][2][4][2], const Unit& u, int wr, int wc, int fr, int fq) const {
        const int row0 = u.pm * 256 + wr * 64 + fr, col0 = u.pn * 256 + wc * 32 + 8 * fq;
        float fs[2][4];
#pragma unroll
        for (int ai = 0; ai < 2; ++ai)
#pragma unroll
            for (int m = 0; m < 4; ++m) {
                const int row = row0 + ai * 128 + m * 16; float s = 0.f;
#pragma unroll
                for (int k = 0; k < 4; ++k) s += SSQKV[(size_t)k * MTOK + row];
                fs[ai][m] = 1.0f / sqrtf(s * (1.0f / 256.0f) + EPS);
            }
#pragma unroll
        for (int ai = 0; ai < 2; ++ai)
#pragma unroll
            for (int m = 0; m < 4; ++m) {
                const int row = row0 + ai * 128 + m * 16;
                const float f = fs[ai][m];
#pragma unroll
                for (int bj = 0; bj < 2; ++bj) store8(KN + (size_t)row * 1024 + col0 + bj * 128, acc[ai][bj][m][0] * f, acc[ai][bj][m][1] * f);
                asm volatile("" ::: "memory");
            }
    }
};
struct EpiVtm {
    static constexpr bool PERM = true, AFTER_DRAIN = false;
    bf16_t* VTM; const float* SSQKV;
    __device__ __forceinline__ void operator()(const f32x4 (&acc)[2][2][4][2], const Unit& u, int wr, int wc, int fr, int fq) const {
        const int row0 = u.pm * 256 + wr * 64 + fr, col0 = u.pn * 256 + wc * 32 + 8 * fq;
#pragma unroll
        for (int bj = 0; bj < 2; ++bj) {
            f32x4 rv[2];
#pragma unroll
            for (int n = 0; n < 2; ++n) {
                const int c = col0 + bj * 128 + 4 * n; f32x4 s = (f32x4){0.f, 0.f, 0.f, 0.f};
#pragma unroll
                for (int k = 0; k < 4; ++k) s += *(const f32x4*)(SSQKV + (size_t)k * MTOK + c);
#pragma unroll
                for (int e = 0; e < 4; ++e) rv[n][e] = 1.0f / sqrtf(s[e] * (1.0f / 256.0f) + EPS);
            }
#pragma unroll
            for (int ai = 0; ai < 2; ++ai)
#pragma unroll
                for (int m = 0; m < 4; ++m) {
                    store8_perm16(VTM + (size_t)(row0 + ai * 128 + m * 16) * MTOK, col0 + bj * 128, acc[ai][bj][m][0] * rv[0], acc[ai][bj][m][1] * rv[1]);
                    asm volatile("" ::: "memory");
                }
        }
    }
};
struct EpiResNorm {
    static constexpr bool PERM = false, AFTER_DRAIN = true;
    const float* Xin; float* Xout; const float* gate; const float* gw; const float* sh; const float* sc; bf16_t* H; float* Fout; int mode;
    float* xbuf; unsigned* cnt; unsigned* tmo;
    __device__ __forceinline__ void fused(f32x4 (&acc)[2][2][4][2], const Unit& u, int wr, int wc, int fr, int fq, LAS unsigned char* lds, int wid, int lane) const {
        LAS float* P = (LAS float*)lds;
        LAS float* S = (LAS float*)(lds + 4096);
        LAS unsigned* flag = (LAS unsigned*)(lds + 4096 + 1024);
        const int row0 = u.pm * 256 + wr * 64 + fr, col0 = u.pn * 256 + wc * 32 + 4 * fq;
        const int bb = u.pm >> 3;
        {
            const float* gp = gate + (size_t)bb * ADAW + col0;
            f32x4 gv[2][2];
#pragma unroll
            for (int bj = 0; bj < 2; ++bj)
#pragma unroll
                for (int n = 0; n < 2; ++n) gv[bj][n] = *(const f32x4*)(gp + bj * 128 + n * 16);
#pragma unroll
            for (int ai = 0; ai < 2; ++ai) {
                f32x4 xi[4][2][2];
#pragma unroll
                for (int m = 0; m < 4; ++m)
#pragma unroll
                    for (int bj = 0; bj < 2; ++bj)
#pragma unroll
                        for (int n = 0; n < 2; ++n) xi[m][bj][n] = *(const f32x4*)(Xin + (size_t)(row0 + ai * 128 + m * 16) * DM + col0 + bj * 128 + n * 16);
#pragma unroll
                for (int m = 0; m < 4; ++m)
#pragma unroll
                    for (int bj = 0; bj < 2; ++bj)
#pragma unroll
                        for (int n = 0; n < 2; ++n) {
                            acc[ai][bj][m][n] = xi[m][bj][n] + gv[bj][n] * acc[ai][bj][m][n];
                            if (Xout) *(f32x4*)(Xout + (size_t)(row0 + ai * 128 + m * 16) * DM + col0 + bj * 128 + n * 16) = acc[ai][bj][m][n];
                        }
#pragma unroll
                for (int m = 0; m < 4; ++m) asm volatile("" : "+v"(acc[ai][0][m][0]), "+v"(acc[ai][0][m][1]), "+v"(acc[ai][1][m][0]), "+v"(acc[ai][1][m][1]));
                asm volatile("" ::: "memory");
            }
        }
#pragma unroll
        for (int ai = 0; ai < 2; ++ai)
#pragma unroll
            for (int m = 0; m < 4; ++m) {
                float q = 0.f;
#pragma unroll
                for (int bj = 0; bj < 2; ++bj)
#pragma unroll
                    for (int n = 0; n < 2; ++n) { const f32x4 x = acc[ai][bj][m][n]; q += (x[0] * x[0] + x[1] * x[1]) + (x[2] * x[2] + x[3] * x[3]); }
                q += shx(q, lane, 16); q += shx(q, lane, 32);
                if (fq == 0) P[(ai * 128 + wr * 64 + m * 16 + fr) * 4 + wc] = q;
            }
        asm volatile("s_waitcnt lgkmcnt(0)" ::: "memory"); __builtin_amdgcn_s_barrier(); asm volatile("" ::: "memory");
        const int row = wid * 32 + (lane & 31);
        if (lane < 32) {
            const f32x4 pp = *(const LAS f32x4*)(P + row * 4);
            const float t = (pp[0] + pp[1]) + (pp[2] + pp[3]);
            __hip_atomic_store(xbuf + (size_t)(u.pm * 256 + row) * 8 + u.pn, t, __ATOMIC_RELAXED, __HIP_MEMORY_SCOPE_AGENT);
        }
        asm volatile("s_waitcnt vmcnt(0)" ::: "memory");
        if (lane == 0) __hip_atomic_fetch_add(cnt + 64 * u.pm, 1u, __ATOMIC_RELAXED, __HIP_MEMORY_SCOPE_AGENT);
        if (wid == 0) {
            unsigned sp = 0u; bool dead = false;
            for (;;) {
                if ((unsigned)__builtin_amdgcn_readfirstlane(__hip_atomic_load(cnt + 64 * u.pm, __ATOMIC_RELAXED, __HIP_MEMORY_SCOPE_AGENT)) >= 64u) break;
                __builtin_amdgcn_s_sleep(2);
                if (++sp > (1u << 22)) { if (lane == 0) __hip_atomic_store(tmo, 1u, __ATOMIC_RELAXED, __HIP_MEMORY_SCOPE_AGENT); dead = true; break; }
            }
            __builtin_amdgcn_fence(__ATOMIC_ACQUIRE, "agent");
            if (lane == 0) flag[0] = dead ? 1u : 0u;
        }
        asm volatile("s_waitcnt vmcnt(0) lgkmcnt(0)" ::: "memory"); __builtin_amdgcn_s_barrier(); asm volatile("" ::: "memory");
        if (lane < 32) {
            const float* slot = xbuf + (size_t)(u.pm * 256 + row) * 8; float t = 0.f;
#pragma unroll
            for (int k = 0; k < 8; ++k) t += __hip_atomic_load(slot + k, __ATOMIC_RELAXED, __HIP_MEMORY_SCOPE_AGENT);
            S[row] = 1.0f / sqrtf(t * (1.0f / DM) + EPS);
        }
        asm volatile("s_waitcnt vmcnt(0) lgkmcnt(0)" ::: "memory"); __builtin_amdgcn_s_barrier(); asm volatile("" ::: "memory");
        {
            f32x4 Av[2][2], Bv[2][2];
#pragma unroll
            for (int bj = 0; bj < 2; ++bj)
#pragma unroll
                for (int n = 0; n < 2; ++n) {
                    const int c = col0 + bj * 128 + n * 16;
                    Av[bj][n] = *(const f32x4*)(gw + c); Bv[bj][n] = (f32x4){0.f, 0.f, 0.f, 0.f};
                    if (mode == 0) { Av[bj][n] = Av[bj][n] * (*(const f32x4*)(sc + (size_t)bb * ADAW + c) + 1.0f); Bv[bj][n] = *(const f32x4*)(sh + (size_t)bb * ADAW + c); }
                }
#pragma unroll
            for (int ai = 0; ai < 2; ++ai)
#pragma unroll
                for (int m = 0; m < 4; ++m) {
                    const int r = ai * 128 + wr * 64 + m * 16 + fr; const float rinv = S[r];
                    const size_t off = (size_t)(u.pm * 256 + r) * DM + col0;
#pragma unroll
                    for (int bj = 0; bj < 2; ++bj)
#pragma unroll
                        for (int n = 0; n < 2; ++n) {
                            const f32x4 y = acc[ai][bj][m][n] * rinv * Av[bj][n] + Bv[bj][n];
                            if (mode == 0) { u32x2 w; w.x = cvt_pk_bf16(y[0], y[1]); w.y = cvt_pk_bf16(y[2], y[3]); *(u32x2*)(H + off + bj * 128 + n * 16) = w; }
                            else *(f32x4*)(Fout + off + bj * 128 + n * 16) = y;
                        }
                }
        }
    }
};

template <int TYPE>
__device__ __forceinline__ void attn_unit(int b, int h, int qb, const bf16_t* __restrict__ Qb, const bf16_t* __restrict__ Kb, const bf16_t* __restrict__ KRb,
                                          const bf16_t* __restrict__ VTb, const float* __restrict__ NF2, const float* __restrict__ gout, bf16_t* __restrict__ OB, LAS unsigned char* lds, const int wv) {
    constexpr int DK = (TYPE == 0) ? 192 : 64, DV = (TYPE == 0) ? 128 : 64;
    constexpr int NQ = DK / 16, NDB = DV / 32;
    constexpr int KN_B = (TYPE == 0) ? 16384 : 8192, KR_B = (TYPE == 0) ? 8192 : 0, VT_B = DV * 128, STG = KN_B + KR_B + VT_B;
    constexpr int KROWB = (TYPE == 0) ? 256 : 128;
    constexpr int BIAS_OFF = 122880;
    constexpr int NI = (TYPE == 0) ? 5 : 2;
    constexpr int LDQ = (TYPE == 0) ? 1536 : 512;
    constexpr int COLOFF = (TYPE == 0) ? 0 : (TYPE == 1 ? 1024 : 1536);
    const int tid = opaque_tid(wv), lane = tid & 63, r32 = lane & 31, hi = lane >> 5;
    const int wid = __builtin_amdgcn_readfirstlane(tid >> 6);
    const int rowbase = b * SEQ, q0 = qb * 256, q0w = q0 + wid * 32;
    const int NT = 4 * (qb + 1), jl = q0w >> 6;

    bf16x8 qf[NQ];
    { const bf16_t* qp = Qb + (size_t)(rowbase + q0w + r32) * LDQ + h * DK + hi * 8;
#pragma unroll
      for (int d0 = 0; d0 < NQ; ++d0) qf[d0] = *(const bf16x8*)(qp + d0 * 16); }
    const int sw = (r32 >> 1) & 7, x15 = r32 & 15;
    int xo[4];
#pragma unroll
    for (int a = 0; a < 4; ++a) xo[a] = ((2 * a + hi) ^ sw) * 16;
    const int kbase = r32 * KROWB, krbase = KN_B + r32 * 128, vbase = KN_B + KR_B + r32 * 128;
    float nfref = 0.f;
    if (TYPE == 2) {
        nfref = NF2[(size_t)(b * 8 + h) * SEQ + q0];
        if (tid * 4 < 256 * (qb + 1)) *(LAS f32x4*)(lds + BIAS_OFF + tid * 16) = *(const f32x4*)(NF2 + (size_t)(b * 8 + h) * SEQ + tid * 4);
    }
    unsigned so0, so1 = 0, so2 = 0, sv0, sv1 = 0;
    if (TYPE == 0) {
        { const int s0 = 64 * (2 * wid) + lane, row = s0 >> 4, ch = (s0 & 15) ^ (row & 15); so0 = (unsigned)((rowbase + row) * 1024 + h * 128 + ch * 8); }
        { const int s1 = 64 * (2 * wid + 1) + lane, row = s1 >> 4, ch = (s1 & 15) ^ (row & 15); so1 = (unsigned)((rowbase + row) * 1024 + h * 128 + ch * 8); }
        { const int s2 = 64 * wid + lane, row = s2 >> 3, ch = (s2 & 7) ^ ((row >> 1) & 7); so2 = (unsigned)((rowbase + row) * 64 + ch * 8); }
        { const int s3 = 64 * (2 * wid) + lane, d = s3 >> 3, c = (s3 & 7) ^ ((d >> 1) & 7); sv0 = (unsigned)((h * 128 + d) * MTOK + rowbase + c * 8); }
        { const int s4 = 64 * (2 * wid + 1) + lane, d = s4 >> 3, c = (s4 & 7) ^ ((d >> 1) & 7); sv1 = (unsigned)((h * 128 + d) * MTOK + rowbase + c * 8); }
    } else {
        { const int s0 = 64 * wid + lane, row = s0 >> 3, ch = (s0 & 7) ^ ((row >> 1) & 7); so0 = (unsigned)((rowbase + row) * 512 + h * 64 + ch * 8); }
        { const int s3 = 64 * wid + lane, d = s3 >> 3, c = (s3 & 7) ^ ((d >> 1) & 7); sv0 = (unsigned)((h * 64 + d) * MTOK + rowbase + c * 8); }
    }
#define ATT_DMA1(gp_, ldsoff_) __builtin_amdgcn_global_load_lds((const unsigned*)(gp_), (LAS unsigned*)(lds + (ldsoff_)), 16, 0, 0)
#define ATT_ISSUE(j, st_) do { const unsigned kj_ = (unsigned)(j) * 64u * ((TYPE == 0) ? 1024u : 512u), vj_ = (unsigned)(j) * 64u; const int sb_ = (st_) * STG; \
        if (TYPE == 0) { ATT_DMA1(Kb + (so0 + kj_), sb_ + (2 * wid) * 1024); ATT_DMA1(Kb + (so1 + kj_), sb_ + (2 * wid + 1) * 1024); ATT_DMA1(KRb + (so2 + (unsigned)(j) * 4096u), sb_ + KN_B + wid * 1024); \
                         ATT_DMA1(VTb + (sv0 + vj_), sb_ + KN_B + KR_B + (2 * wid) * 1024); ATT_DMA1(VTb + (sv1 + vj_), sb_ + KN_B + KR_B + (2 * wid + 1) * 1024); } \
        else { ATT_DMA1(Kb + (so0 + kj_), sb_ + wid * 1024); ATT_DMA1(VTb + (sv0 + vj_), sb_ + KN_B + wid * 1024); } } while (0)

    f32x16 o[NDB];
#pragma unroll
    for (int d = 0; d < NDB; ++d)
#pragma unroll
        for (int r = 0; r < 16; ++r) o[d][r] = 0.f;
    float m_run = -INFINITY, l_run = 0.f, R_run = (TYPE == 1) ? 1.f : 0.f;

    ATT_ISSUE(NT - 1, 0);
    ATT_ISSUE(NT - 2, 1);
    int stg = 0;
    for (int it = 0; it < NT; ++it) {
        const int j = NT - 1 - it, bo = stg * STG;
        if (it + 1 < NT) { if (TYPE == 0) asm volatile("s_waitcnt vmcnt(5) lgkmcnt(0)" ::: "memory"); else asm volatile("s_waitcnt vmcnt(2) lgkmcnt(0)" ::: "memory"); }
        else asm volatile("s_waitcnt vmcnt(0) lgkmcnt(0)" ::: "memory");
        __builtin_amdgcn_s_barrier();
        asm volatile("" ::: "memory");
        if (it + 2 < NT) { const int st2 = (stg == 0) ? 2 : stg - 1; ATT_ISSUE(j - 2, st2); }
        if (j <= jl) {
            f32x16 p0, p1;
            const bool first = (j == jl);
            const float shf = (TYPE == 1 || first) ? 0.f : m_run;
            if (TYPE == 2) {
                const LAS float* bt = (const LAS float*)(lds + BIAS_OFF) + 64 * j;
                const float sub = nfref + shf;
#pragma unroll
                for (int i = 0; i < 8; ++i) { const f32x4 bb = *(const LAS f32x4*)(bt + 8 * i + 4 * hi);
#pragma unroll
                    for (int c = 0; c < 4; ++c) { if (i < 4) p0[4 * i + c] = bb[c] - sub; else p1[4 * (i - 4) + c] = bb[c] - sub; } }
            } else {
#pragma unroll
                for (int r = 0; r < 16; ++r) { p0[r] = -shf; p1[r] = -shf; }
            }
            {
#define ATT_KF(d0_, hh_) (*(const LAS bf16x8*)(lds + bo + (hh_) * 32 * KROWB + ((TYPE == 0) ? (((d0_) < 8) ? (kbase + (((2 * (d0_) + hi) ^ x15) << 4)) : (krbase - (hh_) * 32 * (KROWB - 128) + xo[(d0_) & 3])) : (kbase + xo[(d0_) & 3]))))
                bf16x8 ka[3], kb[3];
                ka[0] = ATT_KF(0, 0); kb[0] = ATT_KF(0, 1); ka[1] = ATT_KF(1, 0); kb[1] = ATT_KF(1, 1);
#pragma unroll
                for (int d0 = 0; d0 < NQ; ++d0) {
                    if (d0 + 2 < NQ) { ka[(d0 + 2) % 3] = ATT_KF(d0 + 2, 0); kb[(d0 + 2) % 3] = ATT_KF(d0 + 2, 1); }
                    __builtin_amdgcn_sched_barrier(0);
                    p0 = __builtin_amdgcn_mfma_f32_32x32x16_bf16(ka[d0 % 3], qf[d0], p0, 0, 0, 0);
                    p1 = __builtin_amdgcn_mfma_f32_32x32x16_bf16(kb[d0 % 3], qf[d0], p1, 0, 0, 0);
                    __builtin_amdgcn_sched_barrier(0);
                }
#undef ATT_KF
            }
            const bool diag = (j == jl);
            float dl_tile = 0.f;
            const int trel = (q0w & 63) + r32;
            if (TYPE == 1) {
                f32x16 B0, B1;
#pragma unroll
                for (int r = 0; r < 16; ++r) {
                    const float z0 = __builtin_amdgcn_fmed3f(p0[r], -80.f, 80.f), z1 = __builtin_amdgcn_fmed3f(p1[r], -80.f, 80.f);
                    const float e0 = fexp2(-z0), e1 = fexp2(-z1);
                    float b0 = __builtin_amdgcn_rcpf(1.0f + e0), b1 = __builtin_amdgcn_rcpf(1.0f + e1);
                    float k0 = e0 * b0, k1 = e1 * b1;
                    B0[r] = b0; B1[r] = b1; p0[r] = k0; p1[r] = k1;
                }
                if (diag) {
#pragma unroll
                    for (int r = 0; r < 16; ++r) { const int kr_ = (r & 3) + 8 * (r >> 2) + 4 * hi;
                        if (kr_ >= trel) { B0[r] = 0.f; p0[r] = 1.f; } if (kr_ + 32 >= trel) { B1[r] = 0.f; p1[r] = 1.f; } }
                }
                float G[8], Go[8];
#pragma unroll
                for (int i = 0; i < 8; ++i) { G[i] = (i < 4) ? ((p0[4 * i] * p0[4 * i + 1]) * (p0[4 * i + 2] * p0[4 * i + 3])) : ((p1[4 * (i - 4)] * p1[4 * (i - 4) + 1]) * (p1[4 * (i - 4) + 2] * p1[4 * (i - 4) + 3]));
                    Go[i] = shx(G[i], lane, 32); }
                float sufp = 1.f;
#pragma unroll
                for (int i = 7; i >= 0; --i) {
                    float w = R_run * sufp * (hi == 0 ? Go[i] : 1.f);
#pragma unroll
                    for (int c = 3; c >= 0; --c) {
                        if (i < 4) { const float kk = p0[4 * i + c]; p0[4 * i + c] = B0[4 * i + c] * w; w *= kk; }
                        else { const float kk = p1[4 * (i - 4) + c]; p1[4 * (i - 4) + c] = B1[4 * (i - 4) + c] * w; w *= kk; }
                    }
                    sufp *= G[i] * Go[i];
                }
                R_run *= sufp;
            } else {
                if (TYPE == 2) { if (diag) {
#pragma unroll
                    for (int r = 0; r < 16; ++r) { const int kr_ = (r & 3) + 8 * (r >> 2) + 4 * hi; if (kr_ > trel) p0[r] = -INFINITY; if (kr_ + 32 > trel) p1[r] = -INFINITY; } } }
                float mx = fmaxf(p0[0], p1[0]);
#pragma unroll
                for (int r = 1; r < 16; ++r) mx = fmaxf(mx, fmaxf(p0[r], p1[r]));
                mx = fmaxf(mx, shx(mx, lane, 32));
                const bool trig = !first && (__builtin_amdgcn_ballot_w64(mx > 8.0f) != 0ull);
                const float dl = first ? mx : (trig ? fmaxf(mx, 0.f) : 0.f);
                const float alpha = first ? 0.f : fexp2(-dl);
                m_run = first ? mx : m_run + dl;
                dl_tile = dl; l_run *= alpha;
                if (trig) {
#pragma unroll
                    for (int d = 0; d < NDB; ++d)
#pragma unroll
                        for (int r = 0; r < 16; ++r) o[d][r] *= alpha;
                }
            }
            {
#define ATT_VF(n_) (*(const LAS bf16x8*)(lds + bo + vbase + ((n_) % NDB) * 4096 + xo[(n_) / NDB]))
                constexpr int NV = 4 * NDB;
                bf16x8 vf[3];
                vf[0] = ATT_VF(0); vf[1] = ATT_VF(1);
                float ls = 0.f;
#pragma unroll
                for (int jp = 0; jp < 4; ++jp) {
                    float e_[8];
#pragma unroll
                    for (int e = 0; e < 8; ++e) { const float x = (jp < 2) ? p0[8 * jp + e] : p1[8 * (jp - 2) + e]; e_[e] = (TYPE == 1) ? x : fexp2(x - dl_tile); }
                    if (TYPE != 1) ls += ((e_[0] + e_[1]) + (e_[2] + e_[3])) + ((e_[4] + e_[5]) + (e_[6] + e_[7]));
                    u32x4 w; w.x = cvt_pk_bf16(e_[0], e_[1]); w.y = cvt_pk_bf16(e_[2], e_[3]); w.z = cvt_pk_bf16(e_[4], e_[5]); w.w = cvt_pk_bf16(e_[6], e_[7]);
                    const bf16x8 pw = __builtin_bit_cast(bf16x8, w);
#pragma unroll
                    for (int d = 0; d < NDB; ++d) {
                        const int n = jp * NDB + d;
                        if (n + 2 < NV) vf[(n + 2) % 3] = ATT_VF(n + 2);
                        __builtin_amdgcn_sched_barrier(0);
                        o[d] = __builtin_amdgcn_mfma_f32_32x32x16_bf16(vf[n % 3], pw, o[d], 0, 0, 0);
                    }
                    __builtin_amdgcn_sched_barrier(0);
                }
                l_run += ls;
#undef ATT_VF
            }
        }
        stg = (stg == 2) ? 0 : stg + 1;
    }
    asm volatile("s_waitcnt lgkmcnt(0)" ::: "memory");
    __builtin_amdgcn_s_barrier();
    asm volatile("" ::: "memory");
#undef ATT_DMA1
#undef ATT_ISSUE
    float inv_l = 1.f;
    if (TYPE != 1) { const float lt = l_run + shx(l_run, lane, 32); inv_l = 1.0f / lt; }
    float ssq = 0.f;
#pragma unroll
    for (int d = 0; d < NDB; ++d)
#pragma unroll
        for (int r = 0; r < 16; ++r) { o[d][r] *= inv_l; ssq += o[d][r] * o[d][r]; }
    ssq += shx(ssq, lane, 32);
    const float rinv = 1.0f / sqrtf(ssq * (1.0f / DV) + EPS);
    constexpr int ROWB = DV * 2 + 16, CH = DV / 8;
    LAS unsigned char* stg_ = lds + wid * (32 * ROWB);
    const float* gp = gout + COLOFF + h * DV + 4 * hi;
#pragma unroll
    for (int d = 0; d < NDB; ++d)
#pragma unroll
        for (int rg = 0; rg < 4; ++rg) {
            const f32x4 g4 = *(const f32x4*)(gp + 32 * d + 8 * rg);
            u32x2 w; w.x = cvt_pk_bf16(o[d][4 * rg] * rinv * g4[0], o[d][4 * rg + 1] * rinv * g4[1]); w.y = cvt_pk_bf16(o[d][4 * rg + 2] * rinv * g4[2], o[d][4 * rg + 3] * rinv * g4[3]);
            *(LAS u32x2*)(stg_ + r32 * ROWB + (32 * d + 8 * rg + 4 * hi) * 2) = w;
        }
    asm volatile("s_waitcnt lgkmcnt(0)" ::: "memory");
    bf16_t* ob = OB + (size_t)(rowbase + q0w) * DM + COLOFF + h * DV;
#pragma unroll
    for (int i = 0; i < CH / 2; ++i) {
        const int row = i * (64 / CH) + lane / CH, ch = lane % CH;
        const u32x4 v = *(const LAS u32x4*)(stg_ + row * ROWB + ch * 16);
        *(u32x4*)(ob + (size_t)row * DM + ch * 8) = v;
    }
}

__device__ __forceinline__ int srccol(int id, int r) {
    if (id == 0) {
        if (r < 768) return r;
        if (r < 1280) return 832 + (r - 768);
        if (r < 1792) return 1344 + (r - 1280);
        if (r < 2304) return 2368 + (r - 1792);
        if (r < 2816) return 2880 + (r - 2304);
        r -= 2816;
        if (r < 64) return 768 + (r >> 1) + (r & 1) * 32;
        if (r < 72) return 3904 + (r - 64);
        return -1;
    }
    if (id == 1) return r < 512 ? 1856 + r : 3392 + (r - 512);
    if (id == 2) { const int h = r / 192, w = r % 192; if (w < 128) return h * 192 + w; const int j = w - 128; return h * 192 + 128 + (j >> 1) + (j & 1) * 32; }
    if (id == 3) return (r >> 7) * 256 + (r & 127);
    if (id == 4) return (r >> 7) * 256 + 128 + (r & 127);
    return r;
}
__device__ __forceinline__ unsigned f2bf(float f) { unsigned u = __builtin_bit_cast(unsigned, f); return (u + 0x7fffu + ((u >> 16) & 1u)) >> 16; }
__device__ __forceinline__ unsigned pk2(float lo, float hi) { return f2bf(lo) | (f2bf(hi) << 16); }
__device__ __forceinline__ void transpose_item(const float* __restrict__ W, int K, int N, bf16_t* __restrict__ WT, int id, const float* __restrict__ gk, LAS float* scr, int item, int nblk, int lane) {
    const int kb = item / nblk, nb = item % nblk, k0 = 64 * kb, n0 = 32 * nb;
    const int sc = srccol(id, n0 + (lane & 31));
    const float* src = W + (size_t)(k0 + (lane >> 5)) * N + (sc < 0 ? 0 : sc);
    float v[32];
#pragma unroll
    for (int i = 0; i < 32; ++i) v[i] = src[(size_t)(2 * i) * N];
    if (sc < 0) {
#pragma unroll
        for (int i = 0; i < 32; ++i) v[i] = 0.f;
    }
    if (gk) {
#pragma unroll
        for (int i = 0; i < 32; ++i) v[i] *= gk[k0 + 2 * i + (lane >> 5)];
    }
#pragma unroll
    for (int i = 0; i < 32; ++i) scr[(2 * i + (lane >> 5)) * 33 + (lane & 31)] = v[i];
    asm volatile("s_waitcnt lgkmcnt(0)" ::: "memory");
    const int c = lane & 7;
#pragma unroll
    for (int j = 0; j < 4; ++j) { const int n = (lane >> 3) + 8 * j; const LAS float* s = scr + (8 * c) * 33 + n;
        u32x4 o; o.x = pk2(s[0 * 33], s[1 * 33]); o.y = pk2(s[2 * 33], s[3 * 33]); o.z = pk2(s[4 * 33], s[5 * 33]); o.w = pk2(s[6 * 33], s[7 * 33]);
        *(u32x4*)(WT + (size_t)(n0 + n) * K + k0 + 8 * c) = o; }
    asm volatile("s_waitcnt lgkmcnt(0)" ::: "memory");
}


#define XB_TMO      128
#define XB_XCNT(j)  (256  + 64 * (j))
#define XB_XSUB(j)  (1280 + 64 * (j))
#define XB_XGEN(j)  (2304 + 64 * (j))
#define XB_TOP      3328
#define XB_TOPGEN   3392
#define XCD_BAR_WORDS 3456
#define XB_SPIN_CAP (1u << 22)
__device__ __forceinline__ unsigned xb_ld(unsigned* p)              { return __hip_atomic_load(p, __ATOMIC_RELAXED, __HIP_MEMORY_SCOPE_AGENT); }
__device__ __forceinline__ unsigned xb_add(unsigned* p, unsigned v) { return __hip_atomic_fetch_add(p, v, __ATOMIC_RELAXED, __HIP_MEMORY_SCOPE_AGENT); }
__device__ __forceinline__ unsigned xb_xcc_id() { return (unsigned)__builtin_amdgcn_s_getreg((3 << 11) | 20) & 0xFu; }
#define XB_SPIN(cond, bar) do { unsigned _sp = 0; while (cond) { __builtin_amdgcn_s_sleep(1); \
    if ((++_sp & 255u) == 0u) { if (xb_ld(&(bar)[XB_TMO])) break; if (_sp > XB_SPIN_CAP) { atomicAdd(&(bar)[XB_TMO], 1u); break; } } } } while (0)
__device__ __forceinline__ void xcd_barrier_complete(unsigned* bar, unsigned x, unsigned& nloc, unsigned& nx) {
    const unsigned G = gridDim.x;
    unsigned sum, cnt, mine, sp = 0u;
    for (;;) {
        sum = 0u; cnt = 0u; mine = 0u;
#pragma unroll
        for (unsigned j = 0; j < 16; ++j) { const unsigned c = xb_ld(&bar[XB_XCNT(j)]); sum += c; cnt += (c > 0u) ? 1u : 0u; mine = (j == x) ? c : mine; }
        if (sum == G) break;
        __builtin_amdgcn_s_sleep(1);
        if ((++sp & 255u) == 0u) { if (xb_ld(&bar[XB_TMO])) break; if (sp > XB_SPIN_CAP) { atomicAdd(&bar[XB_TMO], 1u); break; } }
    }
    nloc = mine > 0u ? mine : 1u; nx = cnt > 0u ? cnt : 1u;
}
__device__ __forceinline__ void xcd_barrier(unsigned* bar, volatile LAS unsigned* st, bool is0) {
    asm volatile("s_waitcnt vmcnt(0)" ::: "memory");
    __syncthreads();
    if (is0) {
        __builtin_amdgcn_s_waitcnt(0);
        const unsigned x = xb_xcc_id();
        unsigned nloc = st[0], nx = st[1];
        if (nloc == 0u) { xcd_barrier_complete(bar, x, nloc, nx); st[0] = nloc; st[1] = nx; }
        const unsigned old = xb_add(&bar[XB_XSUB(x)], 1u);
        const unsigned gen = old / nloc;
        if (old + 1u == (gen + 1u) * nloc) {
            __builtin_amdgcn_fence(__ATOMIC_RELEASE, "agent");
            asm volatile("s_waitcnt vmcnt(0)" ::: "memory");
            const unsigned og = xb_add(&bar[XB_TOP], 1u);
            const unsigned tg = og / nx;
            if (og + 1u == (tg + 1u) * nx) xb_add(&bar[XB_TOPGEN], 1u);
            else XB_SPIN(xb_ld(&bar[XB_TOPGEN]) == tg, bar);
            __builtin_amdgcn_fence(__ATOMIC_ACQUIRE, "agent");
            xb_add(&bar[XB_XGEN(x)], 1u);
            asm volatile("s_waitcnt vmcnt(0)" ::: "memory");
        } else {
            XB_SPIN(xb_ld(&bar[XB_XGEN(x)]) == gen, bar);
            __builtin_amdgcn_fence(__ATOMIC_ACQUIRE, "agent");
            asm volatile("s_waitcnt vmcnt(0)" ::: "memory");
        }
    }
    __syncthreads();
}

struct Args {
    const float *x, *c, *w_ada, *b_ada, *norm_mix, *w_in, *q_norm, *w_uq, *kv_norm, *w_ukv, *b_forget, *out_norm, *w_out, *norm_ffn, *w_ff1, *w_ff2, *final_norm;
    float* out; unsigned char* ws; int ph_lo, ph_hi;
};

__device__ __forceinline__ void prologue_phase(const Args& A, LAS unsigned char* lds, int G, const int wv) {
    const int tid = opaque_tid(wv), lane = tid & 63, wave = __builtin_amdgcn_readfirstlane(tid >> 6);
    unsigned char* ws = A.ws;
    LAS float* cact = (LAS float*)(lds + 69632);
    LAS float* red = (LAS float*)(lds + 102400);
    for (int e = tid; e < 4 * DM; e += 512) { const int bb = e >> 11, k = e & (DM - 1); const float cv = A.c[e]; cact[k * 4 + bb] = cv / (1.0f + expf(-cv)); }
    __syncthreads();
    float* mod = (float*)(ws + WS_MOD);
    for (int t = blockIdx.x; t < 384; t += G) {
        const int l = t / 192, n0 = (t % 192) * 64;
        const float* Wp = A.w_ada + (size_t)l * DM * ADAW + (size_t)(256 * wave) * ADAW + n0 + lane;
        float a0 = 0.f, a1 = 0.f, a2 = 0.f, a3 = 0.f;
#pragma unroll 16
        for (int k = 0; k < 256; ++k) { const float wv = Wp[(size_t)k * ADAW]; const f32x4 ca = *(const LAS f32x4*)(cact + (256 * wave + k) * 4); a0 += ca[0] * wv; a1 += ca[1] * wv; a2 += ca[2] * wv; a3 += ca[3] * wv; }
        red[(wave * 4 + 0) * 64 + lane] = a0; red[(wave * 4 + 1) * 64 + lane] = a1; red[(wave * 4 + 2) * 64 + lane] = a2; red[(wave * 4 + 3) * 64 + lane] = a3;
        __syncthreads();
        if (tid < 256) { const int bb = tid >> 6; float s = 0.f;
#pragma unroll
            for (int w = 0; w < 8; ++w) s += red[(w * 4 + bb) * 64 + lane];
            mod[(size_t)(l * 4 + bb) * ADAW + n0 + lane] = s + A.b_ada[l * ADAW + n0 + lane]; }
        __syncthreads();
        if (tid == 0) { __builtin_amdgcn_fence(__ATOMIC_RELEASE, "agent"); asm volatile("s_waitcnt vmcnt(0)" ::: "memory");
                        __hip_atomic_fetch_add((unsigned*)(ws + WS_CTL) + 4, 1u, __ATOMIC_RELAXED, __HIP_MEMORY_SCOPE_AGENT); }
    }
    f32x2* rope = (f32x2*)(ws + WS_ROPE);
    for (int e = blockIdx.x * 512 + tid; e < SEQ * 32; e += G * 512) {
        const int pos = e >> 5, i = e & 31;
        const double ang = (double)((float)pos * INVF[i]);
        const double n = __builtin_rint(ang * 0.6366197723675814); const int q = (int)n;
        double r = __builtin_fma(-n, 1.5707963267948966, ang); r = __builtin_fma(-n, 6.123233995736766e-17, r);
        const double r2 = r * r;
        const double s = r * (1.0 + r2 * (-1.0 / 6 + r2 * (1.0 / 120 + r2 * (-1.0 / 5040 + r2 * (1.0 / 362880 + r2 * (-1.0 / 39916800 + r2 * (1.0 / 6227020800.0)))))));
        const double cc = 1.0 + r2 * (-0.5 + r2 * (1.0 / 24 + r2 * (-1.0 / 720 + r2 * (1.0 / 40320 + r2 * (-1.0 / 3628800 + r2 * (1.0 / 479001600.0 + r2 * (-1.0 / 87178291200.0)))))));
        double co, si;
        switch (q & 3) { case 0: co = cc; si = s; break; case 1: co = -s; si = cc; break; case 2: co = -cc; si = -s; break; default: co = s; si = -cc; break; }
        rope[e] = (f32x2){(float)co, (float)si};
    }
    LAS float* scr = (LAS float*)(lds + wave * 8448);
    const int gw = blockIdx.x * 8 + wave, NGW = G * 8;
    constexpr int I_IN = 32 * 96, I_INV = 32 * 32, I_UQ = 8 * 48, I_KVK = 4 * 32, I_KVV = 4 * 32, I_OUT = 32 * 64, I_1 = 32 * 256, I_2 = 128 * 64;
    constexpr int PER_L = I_IN + I_INV + I_UQ + I_KVK + I_KVV + I_OUT + I_1 + I_2;
    for (int it = gw; it < 2 * PER_L; it += NGW) {
        const int l = it / PER_L; int r = it % PER_L;
        if (r < I_1) { transpose_item(A.w_ff1 + (size_t)l * DM * DFF, DM, DFF, (bf16_t*)(ws + WS_W1) + (size_t)l * DFF * DM, 5, nullptr, scr, r, 256, lane); continue; } r -= I_1;
        if (r < I_2) { transpose_item(A.w_ff2 + (size_t)l * DFF * DM, DFF, DM, (bf16_t*)(ws + WS_W2) + (size_t)l * DM * DFF, 5, nullptr, scr, r, 64, lane); continue; } r -= I_2;
        if (r < I_IN) { transpose_item(A.w_in + (size_t)l * DM * INW, DM, INW, (bf16_t*)(ws + WS_WIN) + (size_t)l * 3072 * DM, 0, nullptr, scr, r, 96, lane); continue; } r -= I_IN;
        if (r < I_OUT) { transpose_item(A.w_out + (size_t)l * DM * DM, DM, DM, (bf16_t*)(ws + WS_WOUT) + (size_t)l * DM * DM, 5, nullptr, scr, r, 64, lane); continue; } r -= I_OUT;
        if (r < I_INV) { transpose_item(A.w_in + (size_t)l * DM * INW, DM, INW, (bf16_t*)(ws + WS_WINV) + (size_t)l * 1024 * DM, 1, nullptr, scr, r, 32, lane); continue; } r -= I_INV;
        if (r < I_UQ) { transpose_item(A.w_uq + (size_t)l * 512 * 1536, 512, 1536, (bf16_t*)(ws + WS_WUQ) + (size_t)l * 1536 * 512, 2, A.q_norm + l * 512, scr, r, 48, lane); continue; } r -= I_UQ;
        if (r < I_KVK) { transpose_item(A.w_ukv + (size_t)l * 256 * 2048, 256, 2048, (bf16_t*)(ws + WS_WUKVK) + (size_t)l * 1024 * 256, 3, A.kv_norm + l * 256, scr, r, 32, lane); continue; } r -= I_KVK;
        transpose_item(A.w_ukv + (size_t)l * 256 * 2048, 256, 2048, (bf16_t*)(ws + WS_WUKVV) + (size_t)l * 1024 * 256, 4, A.kv_norm + l * 256, scr, r, 32, lane);
    }
}

__device__ __forceinline__ void norm_mod_phase(const float* __restrict__ X, const float* __restrict__ g, const float* __restrict__ sh, const float* __restrict__ sc, bf16_t* __restrict__ H, int G, const int wv) {
    const int tid = opaque_tid(wv), lane = tid & 63, gw = blockIdx.x * 8 + (tid >> 6), NGW = G * 8;
    for (int row = gw; row < MTOK; row += NGW) {
        const int bb = row >> 11;
        const f32x4* xr = (const f32x4*)(X + (size_t)row * DM) + lane;
        f32x4 v[8]; float ss = 0.f;
#pragma unroll
        for (int j = 0; j < 8; ++j) { v[j] = xr[64 * j]; ss += (v[j][0] * v[j][0] + v[j][1] * v[j][1]) + (v[j][2] * v[j][2] + v[j][3] * v[j][3]); }
        const float rinv = 1.0f / sqrtf(wave_sum(ss, lane) * (1.0f / DM) + EPS);
        u32x2* op = (u32x2*)(H + (size_t)row * DM) + lane;
#pragma unroll
        for (int j = 0; j < 8; ++j) { const int c = (lane + 64 * j) * 4;
            const f32x4 gg = *(const f32x4*)(g + c), s1 = *(const f32x4*)(sc + (size_t)bb * ADAW + c), s0 = *(const f32x4*)(sh + (size_t)bb * ADAW + c);
            const f32x4 y = v[j] * rinv * gg * (s1 + 1.0f) + s0;
            u32x2 w; w.x = cvt_pk_bf16(y[0], y[1]); w.y = cvt_pk_bf16(y[2], y[3]); op[64 * j] = w; }
    }
}
__device__ __forceinline__ void fcumsum_task(const float* __restrict__ LOGF, float* __restrict__ NF2, int bh, int lane) {
    const int bb = bh >> 3, h = bh & 7;
    const float* src = LOGF + ((size_t)bb * SEQ + 32 * lane) * 8 + h;
    float v[32]; float tot = 0.f;
#pragma unroll
    for (int i = 0; i < 32; ++i) { tot += src[(size_t)i * 8]; v[i] = tot; }
    float inc = tot;
#pragma unroll
    for (int o = 1; o < 64; o <<= 1) { const float t = __builtin_bit_cast(float, __builtin_amdgcn_ds_bpermute(((lane - o) & 63) << 2, __builtin_bit_cast(int, inc))); if (lane >= o) inc += t; }
    const float excl = inc - tot;
    float* dst = NF2 + (size_t)bh * SEQ + 32 * lane;
#pragma unroll
    for (int i = 0; i < 32; ++i) dst[i] = -(excl + v[i]) * LOG2E;
}

constexpr int N_PHASES = 17;
__global__ void __launch_bounds__(512) fwd_megakernel(Args A) {
    extern __shared__ __attribute__((aligned(16))) unsigned char lds_raw[];
    LAS unsigned char* lds = (LAS unsigned char*)lds_raw;
    const int G = gridDim.x, bx = blockIdx.x;
    const int wv = __builtin_amdgcn_readfirstlane((int)threadIdx.x >> 6);
    unsigned char* ws = A.ws;
    const int lo = A.ph_lo, hi = A.ph_hi;
#if MK_MULTI
#define SEAM(k) do { } while (0)
#else
    cg::grid_group grid = cg::this_grid();
    unsigned* xbar = (unsigned*)(ws + WS_CTL) + 1024;
    volatile LAS unsigned* xst = (volatile LAS unsigned*)(lds + MISC_OFF + 64);
    { const int t0_ = opaque_tid(wv); if (t0_ == 0) { xst[0] = 0u; xst[1] = 0u; (void)xb_add(&xbar[XB_XCNT(xb_xcc_id())], 1u); } }
#define SEAM(k) do { if (lo <= (k) && (k) + 1 < hi) { if (hi > 1000) grid.sync(); else xcd_barrier(xbar, xst, opaque_tid(wv) == 0); } } while (0)
#endif
#ifndef PHMASK
#define PHMASK 0x3ff
#endif
#define EN(t) ((PHMASK >> (t)) & 1)
#ifndef REPMASK
#define REPMASK 0
#endif
#define NREP(t) (((REPMASK >> (t)) & 1) ? 2 : 1)
#define IN(k) (lo <= (k) && (k) < hi)
    float* mod = (float*)(ws + WS_MOD);
    const f32x2* rope = (const f32x2*)(ws + WS_ROPE);
    bf16_t* Hb = (bf16_t*)(ws + WS_H);
    float* Xb = (float*)(ws + WS_X);

    if (EN(0) && IN(0)) {
        prologue_phase(A, lds, G, wv);
        if (opaque_tid(wv) == 0) { unsigned sp = 0u; while (__hip_atomic_load((unsigned*)(ws + WS_CTL) + 4, __ATOMIC_RELAXED, __HIP_MEMORY_SCOPE_AGENT) < 384u && ++sp < (1u << 22)) __builtin_amdgcn_s_sleep(2); }
        __syncthreads();
        __builtin_amdgcn_fence(__ATOMIC_ACQUIRE, "agent");
        norm_mod_phase(A.x, A.norm_mix, mod, mod + DM, Hb, G, wv);
        SEAM(0);
    }

    for (int l = 0; l < 2; ++l) {
        const int P = 1 + 8 * l;
        const float* modl = mod + (size_t)l * 4 * ADAW;
        const float* Xin = (l == 0) ? A.x : Xb;
        if (EN(2) && IN(P + 1)) {
            {
              pg8::Gemm g{Hb, (const bf16_t*)(ws + WS_WIN) + (size_t)l * 3072 * DM, MTOK, 3072, DM};
              pg8::Gemm g2{(const bf16_t*)(ws + WS_WINV) + (size_t)l * 1024 * DM, Hb, 1024, MTOK, DM};
              pg8::TwoOrders S; S.init(MTOK, 3072, bx, 1024, MTOK, (bx + 128) % G, G);
              EpiInBoth E{EpiIn{(bf16_t*)(ws + WS_CQ), (bf16_t*)(ws + WS_CKV), (bf16_t*)(ws + WS_KR), (bf16_t*)(ws + WS_QK4), (float*)(ws + WS_SSQQ), (float*)(ws + WS_SSQKV), (float*)(ws + WS_LOGF), rope, A.b_forget + l * 8},
                          EpiPlain{(bf16_t*)(ws + WS_VTS), MTOK, 0, 1}};
              pg8::gemm_phase(lds, g, S, E, wv, g2); }
            SEAM(P + 1);
        }
        if (EN(3) && IN(P + 2)) {
            for (int rp_ = 0; rp_ < NREP(3); ++rp_) {
#ifndef P3SEL
#define P3SEL 15
#endif
            if (P3SEL & 1) { const int t_ = opaque_tid(wv); if (bx < 32 && (t_ >> 6) == 0) fcumsum_task((const float*)(ws + WS_LOGF), (float*)(ws + WS_NF2), bx, t_ & 63); }
            if (P3SEL & 2) { pg8::Gemm g{(const bf16_t*)(ws + WS_CQ), (const bf16_t*)(ws + WS_WUQ) + (size_t)l * 1536 * 512, MTOK, 1536, 512}; pg8::StaticOrder S; S.init(MTOK, 1536, G, bx);
              EpiUq E{(bf16_t*)(ws + WS_QM), (const float*)(ws + WS_SSQQ), rope};
              pg8::gemm_phase(lds, g, S, E, wv); }
            if (P3SEL & 4) { pg8::Gemm g{(const bf16_t*)(ws + WS_CKV), (const bf16_t*)(ws + WS_WUKVK) + (size_t)l * 1024 * 256, MTOK, 1024, 256}; pg8::StaticOrder S; S.init(MTOK, 1024, G, (bx + 64) % G);
              EpiKn E{(bf16_t*)(ws + WS_KN), (const float*)(ws + WS_SSQKV)};
              pg8::gemm_phase(lds, g, S, E, wv); }
            if (P3SEL & 8) { const int c2 = (bx >= 192) ? (bx + 64) % G : ((bx >= 64 && bx < 128) ? bx : G - 1);
              pg8::Gemm g{(const bf16_t*)(ws + WS_WUKVV) + (size_t)l * 1024 * 256, (const bf16_t*)(ws + WS_CKV), 1024, MTOK, 256}; pg8::StaticOrder S; S.init(1024, MTOK, G, G == 256 ? c2 : bx);
              EpiVtm E{(bf16_t*)(ws + WS_VTM), (const float*)(ws + WS_SSQKV)};
              pg8::gemm_phase(lds, g, S, E, wv); }
            }
            SEAM(P + 2);
        }
        if (EN(4) && IN(P + 3)) {
            unsigned* ctr = (unsigned*)(ws + WS_CTL) + 64 * l;
            volatile LAS int* qslot = (volatile LAS int*)(lds + MISC_OFF);
            const bf16_t* QK4 = (const bf16_t*)(ws + WS_QK4); const size_t QS = (size_t)MTOK * 512;
            const float* gout = A.out_norm + l * DM;
#ifndef ATT_DYNQ
#define ATT_DYNQ 1
#endif
            for (int ui_ = 0;; ++ui_) {
                int idx;
                if (ATT_DYNQ) {
                    if (ui_ == 0) idx = bx;
                    else {
                        if (opaque_tid(wv) == 0) *qslot = G + (int)atomicAdd(ctr, 1u);
                        __syncthreads();
                        idx = *qslot;
                        __syncthreads();
                    }
                } else {
                    idx = (ui_ == 1) ? (511 - bx) : (ui_ * 256 + bx);
                    if (ui_ >= 3 || G != 256) idx = 768;
                }
                if (idx >= 768) break;
                const int code = att_code(idx >> 5), bh = idx & 31, type = code >> 3, qb = code & 7, bb = bh >> 3, h = bh & 7;
                if (type == 0) attn_unit<0>(bb, h, qb, (const bf16_t*)(ws + WS_QM), (const bf16_t*)(ws + WS_KN), (const bf16_t*)(ws + WS_KR), (const bf16_t*)(ws + WS_VTM), nullptr, gout, (bf16_t*)(ws + WS_OB), lds, wv);
                else if (type == 1) attn_unit<1>(bb, h, qb, QK4, QK4 + QS, nullptr, (const bf16_t*)(ws + WS_VTS), nullptr, gout, (bf16_t*)(ws + WS_OB), lds, wv);
                else attn_unit<2>(bb, h, qb, QK4 + 2 * QS, QK4 + 3 * QS, nullptr, (const bf16_t*)(ws + WS_VTS) + (size_t)512 * MTOK, (const float*)(ws + WS_NF2), gout, (bf16_t*)(ws + WS_OB), lds, wv);
            }
            SEAM(P + 3);
        }
        if (EN(5) && IN(P + 4)) {
            pg8::Gemm g{(const bf16_t*)(ws + WS_OB), (const bf16_t*)(ws + WS_WOUT) + (size_t)l * DM * DM, MTOK, DM, DM}; pg8::StaticOrder S; S.init(MTOK, DM, G, bx);
            EpiResNorm E{Xin, Xb, modl + 2 * DM, A.norm_ffn + l * DM, modl + 3 * DM, modl + 4 * DM, Hb, nullptr, 0,
                         (float*)(ws + WS_XCH) + (size_t)(2 * l) * MTOK * 8, (unsigned*)(ws + WS_CTL) + 8192 + (2 * l) * 2048, (unsigned*)(ws + WS_CTL) + 2};
            pg8::gemm_phase(lds, g, S, E, wv);
            SEAM(P + 4);
        }
        if (EN(7) && IN(P + 6)) {
            pg8::Gemm g{Hb, (const bf16_t*)(ws + WS_W1) + (size_t)l * DFF * DM, MTOK, DFF, DM}; pg8::StaticOrder S; S.init(MTOK, DFF, G, bx);
            EpiPlain E{(bf16_t*)(ws + WS_HB), DFF, 1, 0};
            for (int rp_ = 0; rp_ < NREP(7); ++rp_) pg8::gemm_phase(lds, g, S, E, wv);
            SEAM(P + 6);
        }
        if (EN(8) && IN(P + 7)) {
            pg8::Gemm g{(const bf16_t*)(ws + WS_HB), (const bf16_t*)(ws + WS_W2) + (size_t)l * DM * DFF, MTOK, DM, DFF}; pg8::StaticOrder S; S.init(MTOK, DM, G, bx);
            const float* mod1 = mod + (size_t)4 * ADAW;
            EpiResNorm E{Xb, (l == 0) ? Xb : nullptr, modl + 5 * DM, (l == 0) ? A.norm_mix + DM : A.final_norm, mod1 + 0 * DM, mod1 + 1 * DM, Hb, A.out, (l == 0) ? 0 : 1,
                         (float*)(ws + WS_XCH) + (size_t)(2 * l + 1) * MTOK * 8, (unsigned*)(ws + WS_CTL) + 8192 + (2 * l + 1) * 2048, (unsigned*)(ws + WS_CTL) + 2};
            pg8::gemm_phase(lds, g, S, E, wv);
            SEAM(P + 7);
        }
    }
#undef IN
#undef SEAM
}

extern "C" void kernel_launch(void* const* d_in, const int* in_sizes, int n_in, void* d_out, int out_size, void* d_ws, size_t ws_size, hipStream_t stream) {
    static int grid = 0;
    if (grid == 0) {
        if (n_in != 17 || out_size != MTOK * DM || ws_size < WS_END) { fprintf(stderr, "kernel_launch: unexpected problem (n_in %d out %d ws %zu)\n", n_in, out_size, ws_size); grid = -1; return; }
        int dev = 0, cus = 0, per_cu = 0;
        hipGetDevice(&dev);
        hipDeviceGetAttribute(&cus, hipDeviceAttributeMultiprocessorCount, dev);
        if (hipFuncSetAttribute((const void*)fwd_megakernel, hipFuncAttributeMaxDynamicSharedMemorySize, LDS_BYTES) != hipSuccess) { fprintf(stderr, "kernel_launch: hipFuncSetAttribute failed\n"); grid = -1; return; }
        if (hipOccupancyMaxActiveBlocksPerMultiprocessor(&per_cu, (const void*)fwd_megakernel, 512, LDS_BYTES) != hipSuccess || per_cu < 1) { fprintf(stderr, "kernel_launch: occupancy query says %d\n", per_cu); per_cu = 1; }
        (void)hipGetLastError();
        grid = cus * (per_cu < 1 ? 1 : 1);
        if (grid <= 0) grid = 256;
    }
    if (grid < 0) return;
    hipMemsetAsync((char*)d_ws + WS_CTL, 0, CTL_BYTES, stream);
    Args a{};
    a.x = (const float*)d_in[0]; a.c = (const float*)d_in[1]; a.w_ada = (const float*)d_in[2]; a.b_ada = (const float*)d_in[3]; a.norm_mix = (const float*)d_in[4];
    a.w_in = (const float*)d_in[5]; a.q_norm = (const float*)d_in[6]; a.w_uq = (const float*)d_in[7]; a.kv_norm = (const float*)d_in[8]; a.w_ukv = (const float*)d_in[9];
    a.b_forget = (const float*)d_in[10]; a.out_norm = (const float*)d_in[11]; a.w_out = (const float*)d_in[12]; a.norm_ffn = (const float*)d_in[13];
    a.w_ff1 = (const float*)d_in[14]; a.w_ff2 = (const float*)d_in[15]; a.final_norm = (const float*)d_in[16];
    a.out = (float*)d_out; a.ws = (unsigned char*)d_ws;
#if MK_MULTI
    for (int p = 0; p < N_PHASES; ++p) { a.ph_lo = p; a.ph_hi = p + 1; hipLaunchKernelGGL(fwd_megakernel, dim3(grid), dim3(512), LDS_BYTES, stream, a); }
#else
    a.ph_lo = 0; a.ph_hi = N_PHASES;
    void* args[] = {&a};
    hipError_t e = hipLaunchCooperativeKernel((const void*)fwd_megakernel, dim3(grid), dim3(512), args, LDS_BYTES, stream);
    if (e != hipSuccess) fprintf(stderr, "kernel_launch: cooperative launch failed: %s (grid %d)\n", hipGetErrorString(e), grid);
#endif
}
```

```cpp
#include <hip/hip_runtime.h>
#include <hip/hip_cooperative_groups.h>
#include <cstdio>
#include <cstdint>
namespace cg = cooperative_groups;

#ifndef MK_MULTI
#define MK_MULTI 0
#endif

#define LAS __attribute__((address_space(3)))
typedef unsigned short bf16_t;
typedef short bf16x8 __attribute__((ext_vector_type(8)));
typedef float f32x2 __attribute__((ext_vector_type(2)));
typedef float f32x4 __attribute__((ext_vector_type(4)));
typedef float f32x16 __attribute__((ext_vector_type(16)));
typedef unsigned u32x2 __attribute__((ext_vector_type(2)));
typedef unsigned u32x4 __attribute__((ext_vector_type(4)));

constexpr int DM = 2048, SEQ = 2048, MTOK = 8192, DFF = 8192, INW = 3912, ADAW = 12288;
constexpr float EPS = 1e-6f;
constexpr float LOG2E = 1.4426950408889634f;
constexpr float QSCALE64 = 0.125f * LOG2E;
constexpr float QSCALE192 = 0.07216878364870323f * LOG2E;

constexpr size_t MiB = 1u << 20;
constexpr size_t WS_CTL = 0, CTL_BYTES = 65536;
constexpr size_t WS_XCH = 5 * MiB;
constexpr size_t WS_ROPE = 1 * MiB;
constexpr size_t WS_MOD = 2 * MiB;
constexpr size_t WS_SSQQ = 3 * MiB;
constexpr size_t WS_SSQKV = 3 * MiB + 512 * 1024;
constexpr size_t WS_NF2 = 4 * MiB;
constexpr size_t WS_LOGF = 4 * MiB + 512 * 1024;
constexpr size_t WS_WIN = 8 * MiB;
constexpr size_t WS_WINV = 32 * MiB;
constexpr size_t WS_WUQ = 40 * MiB;
constexpr size_t WS_WUKVK = 43 * MiB;
constexpr size_t WS_WUKVV = 44 * MiB;
constexpr size_t WS_WOUT = 48 * MiB;
constexpr size_t WS_W1 = 64 * MiB;
constexpr size_t WS_W2 = 128 * MiB;
constexpr size_t WS_H = 192 * MiB;
constexpr size_t WS_CQ = 224 * MiB;
constexpr size_t WS_CKV = 232 * MiB;
constexpr size_t WS_KR = 236 * MiB;
constexpr size_t WS_QK4 = 240 * MiB;
constexpr size_t WS_VTS = 272 * MiB;
constexpr size_t WS_QM = 288 * MiB;
constexpr size_t WS_KN = 312 * MiB;
constexpr size_t WS_VTM = 328 * MiB;
constexpr size_t WS_OB = 344 * MiB;
constexpr size_t WS_X = 384 * MiB;
constexpr size_t WS_HB = 448 * MiB;
constexpr size_t WS_END = 576 * MiB;

constexpr int LDS_BYTES = 135168;
constexpr int MISC_OFF = 131072;

__device__ const float INVF[32] = {1.0f, 0.7498942613601685f, 0.5623413324356079f, 0.4216965138912201f, 0.3162277638912201f, 0.23713737726211548f, 0.17782793939113617f, 0.133352130651474f, 0.10000000149011612f, 0.07498941570520401f, 0.05623413249850273f, 0.04216965287923813f, 0.03162277489900589f, 0.023713737726211548f, 0.017782794311642647f, 0.01333521492779255f, 0.009999999776482582f, 0.007498941849917173f, 0.005623413249850273f, 0.0042169648222625256f, 0.003162277629598975f, 0.00237137358635664f, 0.0017782794311642647f, 0.0013335214462131262f, 0.0010000000474974513f, 0.0007498942431993783f, 0.000562341301701963f, 0.0004216965171508491f, 0.0003162277571391314f, 0.00023713737027719617f, 0.00017782794020604342f, 0.0001333521504420787f};
__device__ const unsigned char ATT_ORDER[24] = {7, 6, 15, 5, 14, 23, 4, 13, 22, 3, 12, 21, 11, 20, 2, 19, 10, 1, 18, 9, 17, 0, 8, 16};
__device__ __forceinline__ int att_code(int grp) {
    const unsigned long long w = (grp < 12) ? 0xab076692ee2bcc7ull : 0x820114c82a98a8bull;
    return (int)((w >> (5 * ((grp < 12) ? grp : grp - 12))) & 31ull);
}

typedef __bf16 bf16x2_t __attribute__((ext_vector_type(2)));
__device__ __forceinline__ unsigned cvt_pk_bf16(float lo, float hi) { const f32x2 v = {lo, hi}; const bf16x2_t b = __builtin_convertvector(v, bf16x2_t); return __builtin_bit_cast(unsigned, b); }
__device__ __forceinline__ float shx(float v, int lane, int o) { return __builtin_bit_cast(float, __builtin_amdgcn_ds_bpermute((lane ^ o) << 2, __builtin_bit_cast(int, v))); }
__device__ __forceinline__ float wave_sum(float v, int lane) {
#pragma unroll
    for (int o = 1; o < 64; o <<= 1) v += shx(v, lane, o);
    return v;
}
__device__ __forceinline__ int opaque_tid(int wv) { unsigned z = 0u; asm volatile("" : "+v"(z)); return (wv << 6) | (int)__builtin_amdgcn_mbcnt_hi(~0u, __builtin_amdgcn_mbcnt_lo(~0u, z)); }
__device__ __forceinline__ float fexp2(float x) { return __builtin_amdgcn_exp2f(x); }
__device__ __forceinline__ float flog2(float x) { return __builtin_amdgcn_logf(x); }

namespace pg8 {
constexpr int BM = 256, BK = 64, HALF = 128, HTB = HALF * BK * 2, STAGE_BYTES = 8 * HTB, NXCD = 8, WGM = 4;
__host__ __device__ __forceinline__ int lds_byte(int r, int c) { const int st = (r >> 4) * 2 + (c >> 5), rr = r & 15, cc = c & 31, ob = rr * 64 + cc * 2; return st * 1024 + (ob ^ (((ob >> 9) & 1) << 5)); }
__host__ __device__ __forceinline__ void stage_rc(int b, int& R, int& C) { const int st = b / 1024, sb = b % 1024, swz = sb ^ (((sb >> 9) & 1) << 5); R = (st >> 1) * 16 + swz / 64; C = (st & 1) * 32 + (swz % 64) / 2; }
__host__ __device__ __forceinline__ int perm32(int rho) { const int n = rho >> 4, i = rho & 15; return 8 * (i >> 2) + 4 * n + (i & 3); }
struct Unit { int pm, pn, g; };
struct Gemm { const bf16_t* A; const bf16_t* Bt; int M, N, K; };
struct StaticOrder {
    int nM, nN, nwg, G, c;
    __device__ __forceinline__ void init(int M, int N, int G_, int c_) { nM = M / BM; nN = N / BM; nwg = nM * nN; G = G_; c = c_; }
    __device__ __forceinline__ bool next(int i, Unit& u) const {
        const long L = (long)i * G + c; if (L >= nwg) return false;
        int wgid = (int)L; { const int q = nwg / NXCD, r = nwg % NXCD, xcd = wgid % NXCD, off = wgid / NXCD; wgid = (xcd < r ? xcd * (q + 1) : r * (q + 1) + (xcd - r) * q) + off; }
        const int nig = WGM * nN, gid = wgid / nig, fm = gid * WGM, gsz = (nM - fm) < WGM ? (nM - fm) : WGM;
        u.pm = fm + ((wgid % nig) % gsz); u.pn = (wgid % nig) / gsz; u.g = 0; return true;
    }
};
template <class Epi, class Sched>
__device__ __forceinline__ void gemm_phase(LAS unsigned char* lds, const Gemm g, const Sched& S, const Epi& E, const int wv, const Gemm g2) {
    const int tid = opaque_tid(wv), wid = __builtin_amdgcn_readfirstlane(tid >> 6), lane = tid & 63, wr = wid >> 2, wc = wid & 3, fr = lane & 15, fq = lane >> 4;
    const int K = g.K, nt = K / BK;
    unsigned voffA[2], voffB[2];
#pragma unroll
    for (int i = 0; i < 2; ++i) { int R, C; stage_rc(tid * 16 + i * 8192, R, C); const int Rb = Epi::PERM ? ((R & ~31) + perm32(R & 31)) : R;
        voffA[i] = (unsigned)(R * K + C) * 2u; voffB[i] = (unsigned)(Rb * K + C) * 2u; }
    const size_t kstep = (size_t)(BK * 2);
    const size_t hstep = (size_t)HALF * K * 2;
    const size_t tstep = 2 * hstep;
    const unsigned ldsw = (unsigned)wid * 1024u;
    const int aoff = lds_byte(wr * 64 + fr, fq * 8), boff = lds_byte(wc * 32 + fr, fq * 8);
#define PG8_SA(b, h) (((b) * 2 + (h)) * HTB)
#define PG8_SB(b, h) ((4 + (b) * 2 + (h)) * HTB)
#define PG8_STAGE(bufoff, gbase, voff) do { _Pragma("unroll") for (int _i = 0; _i < 2; ++_i) \
        __builtin_amdgcn_global_load_lds((const unsigned*)((const char*)(gbase) + (voff)[_i]), (LAS unsigned*)(lds + (bufoff) + ldsw + _i * 8192), 16, 0, 0); } while (0)
#define PG8_LDA(dst, b, h) do { _Pragma("unroll") for (int m = 0; m < 4; ++m) _Pragma("unroll") for (int k = 0; k < 2; ++k) dst[m][k] = *(const LAS bf16x8*)(lds + PG8_SA(b, h) + aoff + m * 2048 + k * 1024); } while (0)
#define PG8_LDB(dst, b, h) do { _Pragma("unroll") for (int n = 0; n < 2; ++n) _Pragma("unroll") for (int k = 0; k < 2; ++k) dst[n][k] = *(const LAS bf16x8*)(lds + PG8_SB(b, h) + boff + n * 2048 + k * 1024); } while (0)
#define PG8_MMA(ai, bj, At, Bt) do { __builtin_amdgcn_s_setprio(1); _Pragma("unroll") for (int m = 0; m < 4; ++m) _Pragma("unroll") for (int n = 0; n < 2; ++n) _Pragma("unroll") for (int k = 0; k < 2; ++k) \
        acc[ai][bj][m][n] = __builtin_amdgcn_mfma_f32_16x16x32_bf16(Bt[n][k], At[m][k], acc[ai][bj][m][n], 0, 0, 0); __builtin_amdgcn_s_setprio(0); } while (0)
#define PG8_WAIT_V(n) asm volatile("s_waitcnt vmcnt(" #n ")" ::: "memory")
#define PG8_WAIT_L(n) asm volatile("s_waitcnt lgkmcnt(" #n ")" ::: "memory")
#define PG8_BAR __builtin_amdgcn_s_barrier()
#define PG8_SCHED __builtin_amdgcn_sched_barrier(0)
    Unit cur, nxt; int ui = 0;
    if (!S.next(0, cur)) return;
    f32x4 acc[2][2][4][2];
#pragma unroll
    for (int a = 0; a < 2; ++a)
#pragma unroll
        for (int b = 0; b < 2; ++b)
#pragma unroll
            for (int m = 0; m < 4; ++m)
#pragma unroll
                for (int n = 0; n < 2; ++n) acc[a][b][m][n] = (f32x4){0.f, 0.f, 0.f, 0.f};
    bf16x8 At[4][2], B0[2][2], B1[2][2];
    const char* cA = (const char*)(cur.g ? g2.A : g.A) + (size_t)cur.pm * tstep; const char* cB = (const char*)(cur.g ? g2.Bt : g.Bt) + (size_t)cur.pn * tstep;
    PG8_STAGE(PG8_SB(0, 0), cB, voffB); PG8_STAGE(PG8_SB(0, 1), cB + hstep, voffB); PG8_STAGE(PG8_SA(0, 0), cA, voffA); PG8_STAGE(PG8_SA(0, 1), cA + hstep, voffA);
    if (wr == 1) PG8_BAR;
    PG8_WAIT_V(2); PG8_BAR;
    PG8_STAGE(PG8_SB(1, 0), cB + kstep, voffB); PG8_STAGE(PG8_SA(1, 0), cA + kstep, voffA); PG8_STAGE(PG8_SB(1, 1), cB + hstep + kstep, voffB);
    PG8_WAIT_V(6); PG8_BAR;
    for (;;) {
        const bool has_next = S.next(ui + 1, nxt);
        const char* nA = has_next ? (const char*)(nxt.g ? g2.A : g.A) + (size_t)nxt.pm * tstep : cA; const char* nB = has_next ? (const char*)(nxt.g ? g2.Bt : g.Bt) + (size_t)nxt.pn * tstep : cB;
        const int tend = has_next ? nt : nt - 2;
        for (int t = 0; t < tend; t += 2) {
            const bool last = (t == nt - 2);
            const char* a1 = cA + (size_t)(t + 1) * kstep;
            const char* a2 = last ? nA : cA + (size_t)(t + 2) * kstep; const char* b2 = last ? nB : cB + (size_t)(t + 2) * kstep;
            const char* a3 = a2 + kstep; const char* b3 = b2 + kstep;
            PG8_LDB(B0, 0, 0); PG8_LDB(B1, 0, 1); PG8_SCHED; PG8_LDA(At, 0, 0); PG8_STAGE(PG8_SA(1, 1), a1 + hstep, voffA);
            PG8_WAIT_V(8); PG8_WAIT_L(0); PG8_BAR; PG8_MMA(0, 0, At, B0); PG8_MMA(0, 1, At, B1); PG8_BAR; PG8_SCHED;
            PG8_LDA(At, 0, 1); PG8_STAGE(PG8_SB(0, 0), b2, voffB); PG8_STAGE(PG8_SB(0, 1), b2 + hstep, voffB); PG8_STAGE(PG8_SA(0, 0), a2, voffA);
            PG8_WAIT_V(8); PG8_WAIT_L(0); PG8_BAR; PG8_MMA(1, 0, At, B0); PG8_MMA(1, 1, At, B1); PG8_BAR; PG8_SCHED;
            PG8_LDB(B0, 1, 0); PG8_LDB(B1, 1, 1); PG8_SCHED; PG8_LDA(At, 1, 0); PG8_STAGE(PG8_SA(0, 1), a2 + hstep, voffA);
            PG8_WAIT_V(8); PG8_WAIT_L(0); PG8_BAR; PG8_MMA(0, 0, At, B0); PG8_MMA(0, 1, At, B1); PG8_BAR; PG8_SCHED;
            PG8_LDA(At, 1, 1); PG8_STAGE(PG8_SB(1, 0), b3, voffB); PG8_STAGE(PG8_SB(1, 1), b3 + hstep, voffB); PG8_STAGE(PG8_SA(1, 0), a3, voffA);
            PG8_WAIT_V(8); PG8_WAIT_L(0); PG8_BAR; PG8_MMA(1, 0, At, B0); PG8_MMA(1, 1, At, B1); PG8_BAR; PG8_SCHED;
        }
        if (!has_next) {
            const char* a1 = cA + (size_t)(nt - 1) * kstep;
            PG8_LDB(B0, 0, 0); PG8_LDB(B1, 0, 1); PG8_SCHED; PG8_LDA(At, 0, 0); PG8_STAGE(PG8_SA(1, 1), a1 + hstep, voffA);
            PG8_WAIT_V(8); PG8_WAIT_L(0); PG8_BAR; PG8_MMA(0, 0, At, B0); PG8_MMA(0, 1, At, B1); PG8_BAR; PG8_SCHED;
            PG8_LDA(At, 0, 1);
            PG8_WAIT_V(2); PG8_WAIT_L(0); PG8_BAR; PG8_MMA(1, 0, At, B0); PG8_MMA(1, 1, At, B1); PG8_BAR; PG8_SCHED;
            PG8_LDB(B0, 1, 0); PG8_LDB(B1, 1, 1); PG8_SCHED; PG8_LDA(At, 1, 0);
            PG8_WAIT_V(0); PG8_WAIT_L(0); PG8_BAR; PG8_MMA(0, 0, At, B0); PG8_MMA(0, 1, At, B1); PG8_BAR; PG8_SCHED;
            PG8_LDA(At, 1, 1);
            PG8_WAIT_L(0); PG8_BAR; PG8_MMA(1, 0, At, B0); PG8_MMA(1, 1, At, B1); PG8_BAR; PG8_SCHED;
        }
        if (wr == 0) PG8_BAR;
        if constexpr (!Epi::AFTER_DRAIN) { const int t2_ = opaque_tid(wv), w2_ = __builtin_amdgcn_readfirstlane(t2_ >> 6), l2_ = t2_ & 63; E(acc, cur, w2_ >> 2, w2_ & 3, l2_ & 15, l2_ >> 4); }
        if (!has_next) break;
#pragma unroll
        for (int a = 0; a < 2; ++a)
#pragma unroll
            for (int b = 0; b < 2; ++b)
#pragma unroll
                for (int m = 0; m < 4; ++m)
#pragma unroll
                    for (int n = 0; n < 2; ++n) acc[a][b][m][n] = (f32x4){0.f, 0.f, 0.f, 0.f};
        cur = nxt; cA = nA; cB = nB; ++ui;
        if (wr == 1) PG8_BAR;
    }
    PG8_WAIT_V(0);
    PG8_BAR;
    if constexpr (Epi::AFTER_DRAIN) { const int t2_ = opaque_tid(wv), w2_ = __builtin_amdgcn_readfirstlane(t2_ >> 6), l2_ = t2_ & 63; E.fused(acc, cur, w2_ >> 2, w2_ & 3, l2_ & 15, l2_ >> 4, lds, w2_, l2_); }
#undef PG8_SA
#undef PG8_SB
#undef PG8_STAGE
#undef PG8_LDA
#undef PG8_LDB
#undef PG8_MMA
#undef PG8_WAIT_V
#undef PG8_WAIT_L
#undef PG8_BAR
#undef PG8_SCHED
}
template <class Epi, class Sched>
__device__ __forceinline__ void gemm_phase(LAS unsigned char* lds, const Gemm g, const Sched& S, const Epi& E, const int wv) { gemm_phase(lds, g, S, E, wv, g); }
struct TwoOrders {
    StaticOrder s0, s1; int n0;
    __device__ __forceinline__ void init(int M0, int N0, int c0, int M1, int N1, int c1, int G) { s0.init(M0, N0, G, c0); s1.init(M1, N1, G, c1); n0 = (c0 < s0.nwg) ? (s0.nwg - c0 + G - 1) / G : 0; }
    __device__ __forceinline__ bool next(int i, Unit& u) const {
        if (i < n0) { (void)s0.next(i, u); u.g = 0; return true; }
        if (s1.next(i - n0, u)) { u.g = 1; return true; }
        return false;
    }
};
}
using pg8::Unit;

__device__ __forceinline__ void store8(bf16_t* p, const f32x4 v0, const f32x4 v1) {
    u32x4 w; w.x = cvt_pk_bf16(v0[0], v0[1]); w.y = cvt_pk_bf16(v0[2], v0[3]); w.z = cvt_pk_bf16(v1[0], v1[1]); w.w = cvt_pk_bf16(v1[2], v1[3]);
    *(u32x4*)p = w;
}
__device__ __forceinline__ void store8_perm16(bf16_t* rowp, int c0, const f32x4 v0, const f32x4 v1) {
    const int p0 = (c0 & ~15) + ((c0 & 15) >> 1);
    u32x2 a, b; a.x = cvt_pk_bf16(v0[0], v0[1]); a.y = cvt_pk_bf16(v0[2], v0[3]); b.x = cvt_pk_bf16(v1[0], v1[1]); b.y = cvt_pk_bf16(v1[2], v1[3]);
    *(u32x2*)(rowp + p0) = a; *(u32x2*)(rowp + p0 + 8) = b;
}
__device__ __forceinline__ void rope8(f32x4& v0, f32x4& v1, const f32x2* rope, int pos, int i0) {
    const f32x4 a = *(const f32x4*)(rope + pos * 32 + i0), b = *(const f32x4*)(rope + pos * 32 + i0 + 2);
    f32x4 o0, o1;
    o0[0] = v0[0] * a[0] - v0[1] * a[1]; o0[1] = v0[1] * a[0] + v0[0] * a[1];
    o0[2] = v0[2] * a[2] - v0[3] * a[3]; o0[3] = v0[3] * a[2] + v0[2] * a[3];
    o1[0] = v1[0] * b[0] - v1[1] * b[1]; o1[1] = v1[1] * b[0] + v1[0] * b[1];
    o1[2] = v1[2] * b[2] - v1[3] * b[3]; o1[3] = v1[3] * b[2] + v1[2] * b[3];
    v0 = o0; v1 = o1;
}
__device__ __forceinline__ float log_sigmoid_f(float x) { return fminf(x, 0.f) - 0.6931471805599453f * flog2(1.0f + fexp2(-1.4426950408889634f * fabsf(x))); }

struct EpiIn {
    static constexpr bool PERM = true, AFTER_DRAIN = false;
    bf16_t *CQ, *CKV, *KR, *QK4; float *SSQQ, *SSQKV, *LOGF; const f32x2* rope; const float* bforget;
    __device__ __forceinline__ void operator()(const f32x4 (&acc)[2][2][4][2], const Unit& u, int wr, int wc, int fr, int fq) const {
        const int pn = u.pn, row0 = u.pm * 256 + wr * 64 + fr;
        if (pn < 11) {
            bf16_t* base; int ld, col0; float sc = 1.f; float* ssq = nullptr;
            if (pn < 2) { base = CQ; ld = 512; col0 = pn * 256; ssq = SSQQ + (size_t)(pn * 4 + wc) * MTOK; }
            else if (pn == 2) { base = CKV; ld = 256; col0 = 0; ssq = SSQKV + (size_t)wc * MTOK; }
            else { const int t = pn - 3; base = QK4 + (size_t)(t >> 1) * ((size_t)MTOK * 512); ld = 512; col0 = (t & 1) * 256; if (((t >> 1) & 1) == 0) sc = QSCALE64; }
            col0 += wc * 32 + 8 * fq;
#pragma unroll
            for (int ai = 0; ai < 2; ++ai)
#pragma unroll
                for (int m = 0; m < 4; ++m) {
                    const int row = row0 + ai * 128 + m * 16; float s = 0.f;
#pragma unroll
                    for (int bj = 0; bj < 2; ++bj) {
                        const f32x4 v0 = acc[ai][bj][m][0] * sc, v1 = acc[ai][bj][m][1] * sc;
                        s += (v0[0] * v0[0] + v0[1] * v0[1]) + (v0[2] * v0[2] + v0[3] * v0[3]) + (v1[0] * v1[0] + v1[1] * v1[1]) + (v1[2] * v1[2] + v1[3] * v1[3]);
                        store8(base + (size_t)row * ld + col0 + bj * 128, v0, v1);
                    }
                    if (ssq) { const int ln_ = fr + 16 * fq; s += shx(s, ln_, 16); s += shx(s, ln_, 32); if (fq == 0) ssq[row] = s; }
                }
        } else {
            const int cl0 = wc * 32 + 8 * fq;
            if (wc < 2) {
#pragma unroll
                for (int ai = 0; ai < 2; ++ai)
#pragma unroll
                    for (int m = 0; m < 4; ++m) {
                        const int row = row0 + ai * 128 + m * 16;
                        f32x4 v0 = acc[ai][0][m][0], v1 = acc[ai][0][m][1];
                        rope8(v0, v1, rope, row & (SEQ - 1), cl0 >> 1);
                        store8(KR + (size_t)row * 64 + cl0, v0, v1);
                        asm volatile("" ::: "memory");
                    }
            } else if (wc == 2 && fq == 0) {
                const f32x4 b0 = *(const f32x4*)(bforget), b1 = *(const f32x4*)(bforget + 4);
#pragma unroll
                for (int ai = 0; ai < 2; ++ai)
#pragma unroll
                    for (int m = 0; m < 4; ++m) {
                        const int row = row0 + ai * 128 + m * 16;
                        const f32x4 x0 = acc[ai][0][m][0] + b0, x1 = acc[ai][0][m][1] + b1; f32x4 l0, l1;
#pragma unroll
                        for (int c = 0; c < 4; ++c) { l0[c] = log_sigmoid_f(x0[c]); l1[c] = log_sigmoid_f(x1[c]); }
                        *(f32x4*)(LOGF + (size_t)row * 8) = l0; *(f32x4*)(LOGF + (size_t)row * 8 + 4) = l1;
                    }
            }
        }
    }
};
struct EpiPlain {
    static constexpr bool PERM = true, AFTER_DRAIN = false;
    bf16_t* O; int ld; int relu2; int perm16;
    __device__ __forceinline__ void operator()(const f32x4 (&acc)[2][2][4][2], const Unit& u, int wr, int wc, int fr, int fq) const {
        const int row0 = u.pm * 256 + wr * 64 + fr, col0 = u.pn * 256 + wc * 32 + 8 * fq;
#pragma unroll
        for (int ai = 0; ai < 2; ++ai)
#pragma unroll
            for (int m = 0; m < 4; ++m) {
                bf16_t* rowp = O + (size_t)(row0 + ai * 128 + m * 16) * ld + col0;
#pragma unroll
                for (int bj = 0; bj < 2; ++bj) {
                    f32x4 v0 = acc[ai][bj][m][0], v1 = acc[ai][bj][m][1];
                    if (relu2) {
#pragma unroll
                        for (int c = 0; c < 4; ++c) { const float a = fmaxf(v0[c], 0.f), b = fmaxf(v1[c], 0.f); v0[c] = a * a; v1[c] = b * b; }
                    }
                    if (perm16) store8_perm16(rowp - col0, col0 + bj * 128, v0, v1); else store8(rowp + bj * 128, v0, v1);
                }
            }
    }
};
struct EpiInBoth {
    static constexpr bool PERM = true, AFTER_DRAIN = false;
    EpiIn e0; EpiPlain e1;
    __device__ __forceinline__ void operator()(const f32x4 (&acc)[2][2][4][2], const Unit& u, int wr, int wc, int fr, int fq) const {
        if (u.g == 0) e0(acc, u, wr, wc, fr, fq); else e1(acc, u, wr, wc, fr, fq);
    }
};
struct EpiUq {
    static constexpr bool PERM = true, AFTER_DRAIN = false;
    bf16_t* QM; const float* SSQQ; const f32x2* rope;
    __device__ __forceinline__ void operator()(const f32x4 (&acc)[2][2][4][2], const Unit& u, int wr, int wc, int fr, int fq) const {
        const int row0 = u.pm * 256 + wr * 64 + fr, col0 = u.pn * 256 + wc * 32 + 8 * fq;
        float fs[2][4];
#pragma unroll
        for (int ai = 0; ai < 2; ++ai)
#pragma unroll
            for (int m = 0; m < 4; ++m) {
                const int row = row0 + ai * 128 + m * 16; float s = 0.f;
#pragma unroll
                for (int k = 0; k < 8; ++k) s += SSQQ[(size_t)k * MTOK + row];
                fs[ai][m] = QSCALE192 / sqrtf(s * (1.0f / 512.0f) + EPS);
            }
#pragma unroll
        for (int ai = 0; ai < 2; ++ai)
#pragma unroll
            for (int m = 0; m < 4; ++m) {
                const int row = row0 + ai * 128 + m * 16;
                const float f = fs[ai][m];
#pragma unroll
                for (int bj = 0; bj < 2; ++bj) {
                    const int c = col0 + bj * 128, w = c % 192;
                    f32x4 v0 = acc[ai][bj][m][0] * f, v1 = acc[ai][bj][m][1] * f;
                    if (w >= 128) rope8(v0, v1, rope, row & (SEQ - 1), (w - 128) >> 1);
                    store8(QM + (size_t)row * 1536 + c, v0, v1);
                }
                asm volatile("" ::: "memory");
            }
    }
};
struct EpiKn {
    static constexpr bool PERM = true, AFTER_DRAIN = false;
    bf16_t* KN; const float* SSQKV;
    __device__ __forceinline__ void operator()(const f32x4 (&acc)[2][2][4][2], const Unit& u, int wr, int wc, int fr, int fq) const {
        const int row0 = u.pm * 256 + wr * 64 + fr, col0 = u.pn * 256 + wc * 32 + 8 * fq;
        float fs[2][4];
#pragma unroll
        for (int ai = 0; ai < 2; ++ai)
#pragma unroll
            for (int m = 0; m < 4; ++m) {
                const int row = row0 + ai * 128 + m * 16; float s = 0.f;
#pragma unroll
                for (int k = 0; k < 4; ++k) s += SSQKV[(size_t)k * MTOK + row];
                fs[ai][m] = 1.0f / sqrtf(s * (1.0f / 256.0f) + EPS);
            }
#pragma unroll
        for (int ai = 0; ai < 2; ++ai)
#pragma unroll
            for (int m = 0; m < 4; ++m) {
                const int row = row0 + ai * 128 + m * 16;
                const float f = fs[ai][m];
#pragma unroll
                for (int bj = 0; bj < 2; ++bj) store8(KN + (size_t)row * 1024 + col0 + bj * 128, acc[ai][bj][m][0] * f, acc[ai][bj][m][1] * f);
                asm volatile("" ::: "memory");
            }
    }
};
struct EpiVtm {
    static constexpr bool PERM = true, AFTER_DRAIN = false;
    bf16_t* VTM; const float* SSQKV;
    __device__ __forceinline__ void operator()(const f32x4 (&acc)[2][2][4][2], const Unit& u, int wr, int wc, int fr, int fq) const {
        const int row0 = u.pm * 256 + wr * 64 + fr, col0 = u.pn * 256 + wc * 32 + 8 * fq;
#pragma unroll
        for (int bj = 0; bj < 2; ++bj) {
            f32x4 rv[2];
#pragma unroll
            for (int n = 0; n < 2; ++n) {
                const int c = col0 + bj * 128 + 4 * n; f32x4 s = (f32x4){0.f, 0.f, 0.f, 0.f};
#pragma unroll
                for (int k = 0; k < 4; ++k) s += *(const f32x4*)(SSQKV + (size_t)k * MTOK + c);
#pragma unroll
                for (int e = 0; e < 4; ++e) rv[n][e] = 1.0f / sqrtf(s[e] * (1.0f / 256.0f) + EPS);
            }
#pragma unroll
            for (int ai = 0; ai < 2; ++ai)
#pragma unroll
                for (int m = 0; m < 4; ++m) {
                    store8_perm16(VTM + (size_t)(row0 + ai * 128 + m * 16) * MTOK, col0 + bj * 128, acc[ai][bj][m][0] * rv[0], acc[ai][bj][m][1] * rv[1]);
                    asm volatile("" ::: "memory");
                }
        }
    }
};
struct EpiResNorm {
    static constexpr bool PERM = false, AFTER_DRAIN = true;
    const float* Xin; float* Xout; const float* gate; const float* gw; const float* sh; const float* sc; bf16_t* H; float* Fout; int mode;
    float* xbuf; unsigned* cnt; unsigned* tmo;
    __device__ __forceinline__ void fused(f32x4 (&acc)[2][2][4][2], const Unit& u, int wr, int wc, int fr, int fq, LAS unsigned char* lds, int wid, int lane) const {
        LAS float* P = (LAS float*)lds;
        LAS float* S = (LAS float*)(lds + 4096);
        LAS unsigned* flag = (LAS unsigned*)(lds + 4096 + 1024);
        const int row0 = u.pm * 256 + wr * 64 + fr, col0 = u.pn * 256 + wc * 32 + 4 * fq;
        const int bb = u.pm >> 3;
        {
            const float* gp = gate + (size_t)bb * ADAW + col0;
            f32x4 gv[2][2];
#pragma unroll
            for (int bj = 0; bj < 2; ++bj)
#pragma unroll
                for (int n = 0; n < 2; ++n) gv[bj][n] = *(const f32x4*)(gp + bj * 128 + n * 16);
#pragma unroll
            for (int ai = 0; ai < 2; ++ai) {
                f32x4 xi[4][2][2];
#pragma unroll
                for (int m = 0; m < 4; ++m)
#pragma unroll
                    for (int bj = 0; bj < 2; ++bj)
#pragma unroll
                        for (int n = 0; n < 2; ++n) xi[m][bj][n] = *(const f32x4*)(Xin + (size_t)(row0 + ai * 128 + m * 16) * DM + col0 + bj * 128 + n * 16);
#pragma unroll
                for (int m = 0; m < 4; ++m)
#pragma unroll
                    for (int bj = 0; bj < 2; ++bj)
#pragma unroll
                        for (int n = 0; n < 2; ++n) {
                            acc[ai][bj][m][n] = xi[m][bj][n] + gv[bj][n] * acc[ai][bj][m][n];
                            if (Xout) *(f32x4*)(Xout + (size_t)(row0 + ai * 128 + m * 16) * DM + col0 + bj * 128 + n * 16) = acc[ai][bj][m][n];
                        }
#pragma unroll
                for (int m = 0; m < 4; ++m) asm volatile("" : "+v"(acc[ai][0][m][0]), "+v"(acc[ai][0][m][1]), "+v"(acc[ai][1][m][0]), "+v"(acc[ai][1][m][1]));
                asm volatile("" ::: "memory");
            }
        }
#pragma unroll
        for (int ai = 0; ai < 2; ++ai)
#pragma unroll
            for (int m = 0; m < 4; ++m) {
                float q = 0.f;
#pragma unroll
                for (int bj = 0; bj < 2; ++bj)
#pragma unroll
                    for (int n = 0; n < 2; ++n) { const f32x4 x = acc[ai][bj][m][n]; q += (x[0] * x[0] + x[1] * x[1]) + (x[2] * x[2] + x[3] * x[3]); }
                q += shx(q, lane, 16); q += shx(q, lane, 32);
                if (fq == 0) P[(ai * 128 + wr * 64 + m * 16 + fr) * 4 + wc] = q;
            }
        asm volatile("s_waitcnt lgkmcnt(0)" ::: "memory"); __builtin_amdgcn_s_barrier(); asm volatile("" ::: "memory");
        const int row = wid * 32 + (lane & 31);
        if (lane < 32) {
            const f32x4 pp = *(const LAS f32x4*)(P + row * 4);
            const float t = (pp[0] + pp[1]) + (pp[2] + pp[3]);
            __hip_atomic_store(xbuf + (size_t)(u.pm * 256 + row) * 8 + u.pn, t, __ATOMIC_RELAXED, __HIP_MEMORY_SCOPE_AGENT);
        }
        asm volatile("s_waitcnt vmcnt(0)" ::: "memory");
        if (lane == 0) __hip_atomic_fetch_add(cnt + 64 * u.pm, 1u, __ATOMIC_RELAXED, __HIP_MEMORY_SCOPE_AGENT);
        if (wid == 0) {
            unsigned sp = 0u; bool dead = false;
            for (;;) {
                if ((unsigned)__builtin_amdgcn_readfirstlane(__hip_atomic_load(cnt + 64 * u.pm, __ATOMIC_RELAXED, __HIP_MEMORY_SCOPE_AGENT)) >= 64u) break;
                __builtin_amdgcn_s_sleep(2);
                if (++sp > (1u << 22)) { if (lane == 0) __hip_atomic_store(tmo, 1u, __ATOMIC_RELAXED, __HIP_MEMORY_SCOPE_AGENT); dead = true; break; }
            }
            __builtin_amdgcn_fence(__ATOMIC_ACQUIRE, "agent");
            if (lane == 0) flag[0] = dead ? 1u : 0u;
        }
        asm volatile("s_waitcnt vmcnt(0) lgkmcnt(0)" ::: "memory"); __builtin_amdgcn_s_barrier(); asm volatile("" ::: "memory");
        if (lane < 32) {
            const float* slot = xbuf + (size_t)(u.pm * 256 + row) * 8; float t = 0.f;
#pragma unroll
            for (int k = 0; k < 8; ++k) t += __hip_atomic_load(slot + k, __ATOMIC_RELAXED, __HIP_MEMORY_SCOPE_AGENT);
            S[row] = 1.0f / sqrtf(t * (1.0f / DM) + EPS);
        }
        asm volatile("s_waitcnt vmcnt(0) lgkmcnt(0)" ::: "memory"); __builtin_amdgcn_s_barrier(); asm volatile("" ::: "memory");
        {
            f32x4 Av[2][2], Bv[2][2];
#pragma unroll
            for (int bj = 0; bj < 2; ++bj)
#pragma unroll
                for (int n = 0; n < 2; ++n) {
                    const int c = col0 + bj * 128 + n * 16;
                    Av[bj][n] = *(const f32x4*)(gw + c); Bv[bj][n] = (f32x4){0.f, 0.f, 0.f, 0.f};
                    if (mode == 0) { Av[bj][n] = Av[bj][n] * (*(const f32x4*)(sc + (size_t)bb * ADAW + c) + 1.0f); Bv[bj][n] = *(const f32x4*)(sh + (size_t)bb * ADAW + c); }
                }
#pragma unroll
            for (int ai = 0; ai < 2; ++ai)
#pragma unroll
                for (int m = 0; m < 4; ++m) {
                    const int r = ai * 128 + wr * 64 + m * 16 + fr; const float rinv = S[r];
                    const size_t off = (size_t)(u.pm * 256 + r) * DM + col0;
#pragma unroll
                    for (int bj = 0; bj < 2; ++bj)
#pragma unroll
                        for (int n = 0; n < 2; ++n) {
                            const f32x4 y = acc[ai][bj][m][n] * rinv * Av[bj][n] + Bv[bj][n];
                            if (mode == 0) { u32x2 w; w.x = cvt_pk_bf16(y[0], y[1]); w.y = cvt_pk_bf16(y[2], y[3]); *(u32x2*)(H + off + bj * 128 + n * 16) = w; }
                            else *(f32x4*)(Fout + off + bj * 128 + n * 16) = y;
                        }
                }
        }
    }
};

template <int TYPE>
__device__ __forceinline__ void attn_unit(int b, int h, int qb, const bf16_t* __restrict__ Qb, const bf16_t* __restrict__ Kb, const bf16_t* __restrict__ KRb,
                                          const bf16_t* __restrict__ VTb, const float* __restrict__ NF2, const float* __restrict__ gout, bf16_t* __restrict__ OB, LAS unsigned char* lds, const int wv) {
    constexpr int DK = (TYPE == 0) ? 192 : 64, DV = (TYPE == 0) ? 128 : 64;
    constexpr int NQ = DK / 16, NDB = DV / 32;
    constexpr int KN_B = (TYPE == 0) ? 16384 : 8192, KR_B = (TYPE == 0) ? 8192 : 0, VT_B = DV * 128, STG = KN_B + KR_B + VT_B;
    constexpr int KROWB = (TYPE == 0) ? 256 : 128;
    constexpr int BIAS_OFF = 122880;
    constexpr int NI = (TYPE == 0) ? 5 : 2;
    constexpr int LDQ = (TYPE == 0) ? 1536 : 512;
    constexpr int COLOFF = (TYPE == 0) ? 0 : (TYPE == 1 ? 1024 : 1536);
    const int tid = opaque_tid(wv), lane = tid & 63, r32 = lane & 31, hi = lane >> 5;
    const int wid = __builtin_amdgcn_readfirstlane(tid >> 6);
    const int rowbase = b * SEQ, q0 = qb * 256, q0w = q0 + wid * 32;
    const int NT = 4 * (qb + 1), jl = q0w >> 6;

    bf16x8 qf[NQ];
    { const bf16_t* qp = Qb + (size_t)(rowbase + q0w + r32) * LDQ + h * DK + hi * 8;
#pragma unroll
      for (int d0 = 0; d0 < NQ; ++d0) qf[d0] = *(const bf16x8*)(qp + d0 * 16); }
    const int sw = (r32 >> 1) & 7, x15 = r32 & 15;
    int xo[4];
#pragma unroll
    for (int a = 0; a < 4; ++a) xo[a] = ((2 * a + hi) ^ sw) * 16;
    const int kbase = r32 * KROWB, krbase = KN_B + r32 * 128, vbase = KN_B + KR_B + r32 * 128;
    float nfref = 0.f;
    if (TYPE == 2) {
        nfref = NF2[(size_t)(b * 8 + h) * SEQ + q0];
        if (tid * 4 < 256 * (qb + 1)) *(LAS f32x4*)(lds + BIAS_OFF + tid * 16) = *(const f32x4*)(NF2 + (size_t)(b * 8 + h) * SEQ + tid * 4);
    }
    unsigned so0, so1 = 0, so2 = 0, sv0, sv1 = 0;
    if (TYPE == 0) {
        { const int s0 = 64 * (2 * wid) + lane, row = s0 >> 4, ch = (s0 & 15) ^ (row & 15); so0 = (unsigned)((rowbase + row) * 1024 + h * 128 + ch * 8); }
        { const int s1 = 64 * (2 * wid + 1) + lane, row = s1 >> 4, ch = (s1 & 15) ^ (row & 15); so1 = (unsigned)((rowbase + row) * 1024 + h * 128 + ch * 8); }
        { const int s2 = 64 * wid + lane, row = s2 >> 3, ch = (s2 & 7) ^ ((row >> 1) & 7); so2 = (unsigned)((rowbase + row) * 64 + ch * 8); }
        { const int s3 = 64 * (2 * wid) + lane, d = s3 >> 3, c = (s3 & 7) ^ ((d >> 1) & 7); sv0 = (unsigned)((h * 128 + d) * MTOK + rowbase + c * 8); }
        { const int s4 = 64 * (2 * wid + 1) + lane, d = s4 >> 3, c = (s4 & 7) ^ ((d >> 1) & 7); sv1 = (unsigned)((h * 128 + d) * MTOK + rowbase + c * 8); }
    } else {
        { const int s0 = 64 * wid + lane, row = s0 >> 3, ch = (s0 & 7) ^ ((row >> 1) & 7); so0 = (unsigned)((rowbase + row) * 512 + h * 64 + ch * 8); }
        { const int s3 = 64 * wid + lane, d = s3 >> 3, c = (s3 & 7) ^ ((d >> 1) & 7); sv0 = (unsigned)((h * 64 + d) * MTOK + rowbase + c * 8); }
    }
#define ATT_DMA1(gp_, ldsoff_) __builtin_amdgcn_global_load_lds((const unsigned*)(gp_), (LAS unsigned*)(lds + (ldsoff_)), 16, 0, 0)
#define ATT_ISSUE(j, st_) do { const unsigned kj_ = (unsigned)(j) * 64u * ((TYPE == 0) ? 1024u : 512u), vj_ = (unsigned)(j) * 64u; const int sb_ = (st_) * STG; \
        if (TYPE == 0) { ATT_DMA1(Kb + (so0 + kj_), sb_ + (2 * wid) * 1024); ATT_DMA1(Kb + (so1 + kj_), sb_ + (2 * wid + 1) * 1024); ATT_DMA1(KRb + (so2 + (unsigned)(j) * 4096u), sb_ + KN_B + wid * 1024); \
                         ATT_DMA1(VTb + (sv0 + vj_), sb_ + KN_B + KR_B + (2 * wid) * 1024); ATT_DMA1(VTb + (sv1 + vj_), sb_ + KN_B + KR_B + (2 * wid + 1) * 1024); } \
        else { ATT_DMA1(Kb + (so0 + kj_), sb_ + wid * 1024); ATT_DMA1(VTb + (sv0 + vj_), sb_ + KN_B + wid * 1024); } } while (0)

    f32x16 o[NDB];
#pragma unroll
    for (int d = 0; d < NDB; ++d)
#pragma unroll
        for (int r = 0; r < 16; ++r) o[d][r] = 0.f;
    float m_run = -INFINITY, l_run = 0.f, R_run = (TYPE == 1) ? 1.f : 0.f;

    ATT_ISSUE(NT - 1, 0);
    ATT_ISSUE(NT - 2, 1);
    int stg = 0;
    for (int it = 0; it < NT; ++it) {
        const int j = NT - 1 - it, bo = stg * STG;
        if (it + 1 < NT) { if (TYPE == 0) asm volatile("s_waitcnt vmcnt(5) lgkmcnt(0)" ::: "memory"); else asm volatile("s_waitcnt vmcnt(2) lgkmcnt(0)" ::: "memory"); }
        else asm volatile("s_waitcnt vmcnt(0) lgkmcnt(0)" ::: "memory");
        __builtin_amdgcn_s_barrier();
        asm volatile("" ::: "memory");
        if (it + 2 < NT) { const int st2 = (stg == 0) ? 2 : stg - 1; ATT_ISSUE(j - 2, st2); }
        if (j <= jl) {
            f32x16 p0, p1;
            const bool first = (j == jl);
            const float shf = (TYPE == 1 || first) ? 0.f : m_run;
            if (TYPE == 2) {
                const LAS float* bt = (const LAS float*)(lds + BIAS_OFF) + 64 * j;
                const float sub = nfref + shf;
#pragma unroll
                for (int i = 0; i < 8; ++i) { const f32x4 bb = *(const LAS f32x4*)(bt + 8 * i + 4 * hi);
#pragma unroll
                    for (int c = 0; c < 4; ++c) { if (i < 4) p0[4 * i + c] = bb[c] - sub; else p1[4 * (i - 4) + c] = bb[c] - sub; } }
            } else {
#pragma unroll
                for (int r = 0; r < 16; ++r) { p0[r] = -shf; p1[r] = -shf; }
            }
            {
#define ATT_KF(d0_, hh_) (*(const LAS bf16x8*)(lds + bo + (hh_) * 32 * KROWB + ((TYPE == 0) ? (((d0_) < 8) ? (kbase + (((2 * (d0_) + hi) ^ x15) << 4)) : (krbase - (hh_) * 32 * (KROWB - 128) + xo[(d0_) & 3])) : (kbase + xo[(d0_) & 3]))))
                bf16x8 ka[3], kb[3];
                ka[0] = ATT_KF(0, 0); kb[0] = ATT_KF(0, 1); ka[1] = ATT_KF(1, 0); kb[1] = ATT_KF(1, 1);
#pragma unroll
                for (int d0 = 0; d0 < NQ; ++d0) {
                    if (d0 + 2 < NQ) { ka[(d0 + 2) % 3] = ATT_KF(d0 + 2, 0); kb[(d0 + 2) % 3] = ATT_KF(d0 + 2, 1); }
                    __builtin_amdgcn_sched_barrier(0);
                    p0 = __builtin_amdgcn_mfma_f32_32x32x16_bf16(ka[d0 % 3], qf[d0], p0, 0, 0, 0);
                    p1 = __builtin_amdgcn_mfma_f32_32x32x16_bf16(kb[d0 % 3], qf[d0], p1, 0, 0, 0);
                    __builtin_amdgcn_sched_barrier(0);
                }
#undef ATT_KF
            }
            const bool diag = (j == jl);
            float dl_tile = 0.f;
            const int trel = (q0w & 63) + r32;
            if (TYPE == 1) {
                f32x16 B0, B1;
#pragma unroll
                for (int r = 0; r < 16; ++r) {
                    const int kr_ = (r & 3) + 8 * (r >> 2) + 4 * hi;
                    const float z0 = __builtin_amdgcn_fmed3f(p0[r], -80.f, 80.f), z1 = __builtin_amdgcn_fmed3f(p1[r], -80.f, 80.f);
                    const float e0 = fexp2(-z0), e1 = fexp2(-z1);
                    float b0 = __builtin_amdgcn_rcpf(1.0f + e0), b1 = __builtin_amdgcn_rcpf(1.0f + e1);
                    float k0 = e0 * b0, k1 = e1 * b1;
                    if (diag) { if (kr_ >= trel) { b0 = 0.f; k0 = 1.f; } if (kr_ + 32 >= trel) { b1 = 0.f; k1 = 1.f; } }
                    B0[r] = b0; B1[r] = b1; p0[r] = k0; p1[r] = k1;
                }
                float G[8], Go[8];
#pragma unroll
                for (int i = 0; i < 8; ++i) { G[i] = (i < 4) ? ((p0[4 * i] * p0[4 * i + 1]) * (p0[4 * i + 2] * p0[4 * i + 3])) : ((p1[4 * (i - 4)] * p1[4 * (i - 4) + 1]) * (p1[4 * (i - 4) + 2] * p1[4 * (i - 4) + 3]));
                    Go[i] = shx(G[i], lane, 32); }
                float sufp = 1.f;
#pragma unroll
                for (int i = 7; i >= 0; --i) {
                    float w = R_run * sufp * (hi == 0 ? Go[i] : 1.f);
#pragma unroll
                    for (int c = 3; c >= 0; --c) {
                        if (i < 4) { const float kk = p0[4 * i + c]; p0[4 * i + c] = B0[4 * i + c] * w; w *= kk; }
                        else { const float kk = p1[4 * (i - 4) + c]; p1[4 * (i - 4) + c] = B1[4 * (i - 4) + c] * w; w *= kk; }
                    }
                    sufp *= G[i] * Go[i];
                }
                R_run *= sufp;
            } else {
                if (TYPE == 2) { if (diag) {
#pragma unroll
                    for (int r = 0; r < 16; ++r) { const int kr_ = (r & 3) + 8 * (r >> 2) + 4 * hi; if (kr_ > trel) p0[r] = -INFINITY; if (kr_ + 32 > trel) p1[r] = -INFINITY; } } }
                float mx = fmaxf(p0[0], p1[0]);
#pragma unroll
                for (int r = 1; r < 16; ++r) mx = fmaxf(mx, fmaxf(p0[r], p1[r]));
                mx = fmaxf(mx, shx(mx, lane, 32));
                const bool trig = !first && (__builtin_amdgcn_ballot_w64(mx > 8.0f) != 0ull);
                const float dl = first ? mx : (trig ? fmaxf(mx, 0.f) : 0.f);
                const float alpha = first ? 0.f : fexp2(-dl);
                m_run = first ? mx : m_run + dl;
                dl_tile = dl; l_run *= alpha;
                if (trig) {
#pragma unroll
                    for (int d = 0; d < NDB; ++d)
#pragma unroll
                        for (int r = 0; r < 16; ++r) o[d][r] *= alpha;
                }
            }
            {
#define ATT_VF(n_) (*(const LAS bf16x8*)(lds + bo + vbase + ((n_) % NDB) * 4096 + xo[(n_) / NDB]))
                constexpr int NV = 4 * NDB;
                bf16x8 vf[3];
                vf[0] = ATT_VF(0); vf[1] = ATT_VF(1);
                float ls = 0.f;
#pragma unroll
                for (int jp = 0; jp < 4; ++jp) {
                    float e_[8];
#pragma unroll
                    for (int e = 0; e < 8; ++e) { const float x = (jp < 2) ? p0[8 * jp + e] : p1[8 * (jp - 2) + e]; e_[e] = (TYPE == 1) ? x : fexp2(x - dl_tile); }
                    if (TYPE != 1) ls += ((e_[0] + e_[1]) + (e_[2] + e_[3])) + ((e_[4] + e_[5]) + (e_[6] + e_[7]));
                    u32x4 w; w.x = cvt_pk_bf16(e_[0], e_[1]); w.y = cvt_pk_bf16(e_[2], e_[3]); w.z = cvt_pk_bf16(e_[4], e_[5]); w.w = cvt_pk_bf16(e_[6], e_[7]);
                    const bf16x8 pw = __builtin_bit_cast(bf16x8, w);
#pragma unroll
                    for (int d = 0; d < NDB; ++d) {
                        const int n = jp * NDB + d;
                        if (n + 2 < NV) vf[(n + 2) % 3] = ATT_VF(n + 2);
                        __builtin_amdgcn_sched_barrier(0);
                        o[d] = __builtin_amdgcn_mfma_f32_32x32x16_bf16(vf[n % 3], pw, o[d], 0, 0, 0);
                    }
                    __builtin_amdgcn_sched_barrier(0);
                }
                l_run += ls;
#undef ATT_VF
            }
        }
        stg = (stg == 2) ? 0 : stg + 1;
    }
    asm volatile("s_waitcnt lgkmcnt(0)" ::: "memory");
    __builtin_amdgcn_s_barrier();
    asm volatile("" ::: "memory");
#undef ATT_DMA1
#undef ATT_ISSUE
    float inv_l = 1.f;
    if (TYPE != 1) { const float lt = l_run + shx(l_run, lane, 32); inv_l = 1.0f / lt; }
    float ssq = 0.f;
#pragma unroll
    for (int d = 0; d < NDB; ++d)
#pragma unroll
        for (int r = 0; r < 16; ++r) { o[d][r] *= inv_l; ssq += o[d][r] * o[d][r]; }
    ssq += shx(ssq, lane, 32);
    const float rinv = 1.0f / sqrtf(ssq * (1.0f / DV) + EPS);
    constexpr int ROWB = DV * 2 + 16, CH = DV / 8;
    LAS unsigned char* stg_ = lds + wid * (32 * ROWB);
    const float* gp = gout + COLOFF + h * DV + 4 * hi;
#pragma unroll
    for (int d = 0; d < NDB; ++d)
#pragma unroll
        for (int rg = 0; rg < 4; ++rg) {
            const f32x4 g4 = *(const f32x4*)(gp + 32 * d + 8 * rg);
            u32x2 w; w.x = cvt_pk_bf16(o[d][4 * rg] * rinv * g4[0], o[d][4 * rg + 1] * rinv * g4[1]); w.y = cvt_pk_bf16(o[d][4 * rg + 2] * rinv * g4[2], o[d][4 * rg + 3] * rinv * g4[3]);
            *(LAS u32x2*)(stg_ + r32 * ROWB + (32 * d + 8 * rg + 4 * hi) * 2) = w;
        }
    asm volatile("s_waitcnt lgkmcnt(0)" ::: "memory");
    bf16_t* ob = OB + (size_t)(rowbase + q0w) * DM + COLOFF + h * DV;
#pragma unroll
    for (int i = 0; i < CH / 2; ++i) {
        const int row = i * (64 / CH) + lane / CH, ch = lane % CH;
        const u32x4 v = *(const LAS u32x4*)(stg_ + row * ROWB + ch * 16);
        *(u32x4*)(ob + (size_t)row * DM + ch * 8) = v;
    }
}

__device__ __forceinline__ int srccol(int id, int r) {
    if (id == 0) {
        if (r < 768) return r;
        if (r < 1280) return 832 + (r - 768);
        if (r < 1792) return 1344 + (r - 1280);
        if (r < 2304) return 2368 + (r - 1792);
        if (r < 2816) return 2880 + (r - 2304);
        r -= 2816;
        if (r < 64) return 768 + (r >> 1) + (r & 1) * 32;
        if (r < 72) return 3904 + (r - 64);
        return -1;
    }
    if (id == 1) return r < 512 ? 1856 + r : 3392 + (r - 512);
    if (id == 2) { const int h = r / 192, w = r % 192; if (w < 128) return h * 192 + w; const int j = w - 128; return h * 192 + 128 + (j >> 1) + (j & 1) * 32; }
    if (id == 3) return (r >> 7) * 256 + (r & 127);
    if (id == 4) return (r >> 7) * 256 + 128 + (r & 127);
    return r;
}
__device__ __forceinline__ unsigned f2bf(float f) { unsigned u = __builtin_bit_cast(unsigned, f); return (u + 0x7fffu + ((u >> 16) & 1u)) >> 16; }
__device__ __forceinline__ unsigned pk2(float lo, float hi) { return f2bf(lo) | (f2bf(hi) << 16); }
__device__ __forceinline__ void transpose_item(const float* __restrict__ W, int K, int N, bf16_t* __restrict__ WT, int id, const float* __restrict__ gk, LAS float* scr, int item, int nblk, int lane) {
    const int kb = item / nblk, nb = item % nblk, k0 = 64 * kb, n0 = 32 * nb;
    const int sc = srccol(id, n0 + (lane & 31));
    const float* src = W + (size_t)(k0 + (lane >> 5)) * N + (sc < 0 ? 0 : sc);
    float v[32];
#pragma unroll
    for (int i = 0; i < 32; ++i) v[i] = src[(size_t)(2 * i) * N];
    if (sc < 0) {
#pragma unroll
        for (int i = 0; i < 32; ++i) v[i] = 0.f;
    }
    if (gk) {
#pragma unroll
        for (int i = 0; i < 32; ++i) v[i] *= gk[k0 + 2 * i + (lane >> 5)];
    }
#pragma unroll
    for (int i = 0; i < 32; ++i) scr[(2 * i + (lane >> 5)) * 33 + (lane & 31)] = v[i];
    asm volatile("s_waitcnt lgkmcnt(0)" ::: "memory");
    const int c = lane & 7;
#pragma unroll
    for (int j = 0; j < 4; ++j) { const int n = (lane >> 3) + 8 * j; const LAS float* s = scr + (8 * c) * 33 + n;
        u32x4 o; o.x = pk2(s[0 * 33], s[1 * 33]); o.y = pk2(s[2 * 33], s[3 * 33]); o.z = pk2(s[4 * 33], s[5 * 33]); o.w = pk2(s[6 * 33], s[7 * 33]);
        *(u32x4*)(WT + (size_t)(n0 + n) * K + k0 + 8 * c) = o; }
    asm volatile("s_waitcnt lgkmcnt(0)" ::: "memory");
}


#define XB_TMO      128
#define XB_XCNT(j)  (256  + 64 * (j))
#define XB_XSUB(j)  (1280 + 64 * (j))
#define XB_XGEN(j)  (2304 + 64 * (j))
#define XB_TOP      3328
#define XB_TOPGEN   3392
#define XCD_BAR_WORDS 3456
#define XB_SPIN_CAP (1u << 22)
__device__ __forceinline__ unsigned xb_ld(unsigned* p)              { return __hip_atomic_load(p, __ATOMIC_RELAXED, __HIP_MEMORY_SCOPE_AGENT); }
__device__ __forceinline__ unsigned xb_add(unsigned* p, unsigned v) { return __hip_atomic_fetch_add(p, v, __ATOMIC_RELAXED, __HIP_MEMORY_SCOPE_AGENT); }
__device__ __forceinline__ unsigned xb_xcc_id() { return (unsigned)__builtin_amdgcn_s_getreg((3 << 11) | 20) & 0xFu; }
#define XB_SPIN(cond, bar) do { unsigned _sp = 0; while (cond) { __builtin_amdgcn_s_sleep(1); \
    if ((++_sp & 255u) == 0u) { if (xb_ld(&(bar)[XB_TMO])) break; if (_sp > XB_SPIN_CAP) { atomicAdd(&(bar)[XB_TMO], 1u); break; } } } } while (0)
__device__ __forceinline__ void xcd_barrier_complete(unsigned* bar, unsigned x, unsigned& nloc, unsigned& nx) {
    const unsigned G = gridDim.x;
    unsigned sum, cnt, mine, sp = 0u;
    for (;;) {
        sum = 0u; cnt = 0u; mine = 0u;
#pragma unroll
        for (unsigned j = 0; j < 16; ++j) { const unsigned c = xb_ld(&bar[XB_XCNT(j)]); sum += c; cnt += (c > 0u) ? 1u : 0u; mine = (j == x) ? c : mine; }
        if (sum == G) break;
        __builtin_amdgcn_s_sleep(1);
        if ((++sp & 255u) == 0u) { if (xb_ld(&bar[XB_TMO])) break; if (sp > XB_SPIN_CAP) { atomicAdd(&bar[XB_TMO], 1u); break; } }
    }
    nloc = mine > 0u ? mine : 1u; nx = cnt > 0u ? cnt : 1u;
}
__device__ __forceinline__ void xcd_barrier(unsigned* bar, volatile LAS unsigned* st, bool is0) {
    asm volatile("s_waitcnt vmcnt(0)" ::: "memory");
    __syncthreads();
    if (is0) {
        __builtin_amdgcn_s_waitcnt(0);
        const unsigned x = xb_xcc_id();
        unsigned nloc = st[0], nx = st[1];
        if (nloc == 0u) { xcd_barrier_complete(bar, x, nloc, nx); st[0] = nloc; st[1] = nx; }
        const unsigned old = xb_add(&bar[XB_XSUB(x)], 1u);
        const unsigned gen = old / nloc;
        if (old + 1u == (gen + 1u) * nloc) {
            __builtin_amdgcn_fence(__ATOMIC_RELEASE, "agent");
            asm volatile("s_waitcnt vmcnt(0)" ::: "memory");
            const unsigned og = xb_add(&bar[XB_TOP], 1u);
            const unsigned tg = og / nx;
            if (og + 1u == (tg + 1u) * nx) xb_add(&bar[XB_TOPGEN], 1u);
            else XB_SPIN(xb_ld(&bar[XB_TOPGEN]) == tg, bar);
            __builtin_amdgcn_fence(__ATOMIC_ACQUIRE, "agent");
            xb_add(&bar[XB_XGEN(x)], 1u);
            asm volatile("s_waitcnt vmcnt(0)" ::: "memory");
        } else {
            XB_SPIN(xb_ld(&bar[XB_XGEN(x)]) == gen, bar);
            __builtin_amdgcn_fence(__ATOMIC_ACQUIRE, "agent");
            asm volatile("s_waitcnt vmcnt(0)" ::: "memory");
        }
    }
    __syncthreads();
}

struct Args {
    const float *x, *c, *w_ada, *b_ada, *norm_mix, *w_in, *q_norm, *w_uq, *kv_norm, *w_ukv, *b_forget, *out_norm, *w_out, *norm_ffn, *w_ff1, *w_ff2, *final_norm;
    float* out; unsigned char* ws; int ph_lo, ph_hi;
};

__device__ __forceinline__ void prologue_phase(const Args& A, LAS unsigned char* lds, int G, const int wv) {
    const int tid = opaque_tid(wv), lane = tid & 63, wave = __builtin_amdgcn_readfirstlane(tid >> 6);
    unsigned char* ws = A.ws;
    LAS float* cact = (LAS float*)(lds + 69632);
    LAS float* red = (LAS float*)(lds + 102400);
    for (int e = tid; e < 4 * DM; e += 512) { const int bb = e >> 11, k = e & (DM - 1); const float cv = A.c[e]; cact[k * 4 + bb] = cv / (1.0f + expf(-cv)); }
    __syncthreads();
    float* mod = (float*)(ws + WS_MOD);
    for (int t = blockIdx.x; t < 384; t += G) {
        const int l = t / 192, n0 = (t % 192) * 64;
        const float* Wp = A.w_ada + (size_t)l * DM * ADAW + (size_t)(256 * wave) * ADAW + n0 + lane;
        float a0 = 0.f, a1 = 0.f, a2 = 0.f, a3 = 0.f;
#pragma unroll 16
        for (int k = 0; k < 256; ++k) { const float wv = Wp[(size_t)k * ADAW]; const f32x4 ca = *(const LAS f32x4*)(cact + (256 * wave + k) * 4); a0 += ca[0] * wv; a1 += ca[1] * wv; a2 += ca[2] * wv; a3 += ca[3] * wv; }
        red[(wave * 4 + 0) * 64 + lane] = a0; red[(wave * 4 + 1) * 64 + lane] = a1; red[(wave * 4 + 2) * 64 + lane] = a2; red[(wave * 4 + 3) * 64 + lane] = a3;
        __syncthreads();
        if (tid < 256) { const int bb = tid >> 6; float s = 0.f;
#pragma unroll
            for (int w = 0; w < 8; ++w) s += red[(w * 4 + bb) * 64 + lane];
            mod[(size_t)(l * 4 + bb) * ADAW + n0 + lane] = s + A.b_ada[l * ADAW + n0 + lane]; }
        __syncthreads();
        if (tid == 0) { __builtin_amdgcn_fence(__ATOMIC_RELEASE, "agent"); asm volatile("s_waitcnt vmcnt(0)" ::: "memory");
                        __hip_atomic_fetch_add((unsigned*)(ws + WS_CTL) + 4, 1u, __ATOMIC_RELAXED, __HIP_MEMORY_SCOPE_AGENT); }
    }
    f32x2* rope = (f32x2*)(ws + WS_ROPE);
    for (int e = blockIdx.x * 512 + tid; e < SEQ * 32; e += G * 512) {
        const int pos = e >> 5, i = e & 31;
        const double ang = (double)((float)pos * INVF[i]);
        const double n = __builtin_rint(ang * 0.6366197723675814); const int q = (int)n;
        double r = __builtin_fma(-n, 1.5707963267948966, ang); r = __builtin_fma(-n, 6.123233995736766e-17, r);
        const double r2 = r * r;
        const double s = r * (1.0 + r2 * (-1.0 / 6 + r2 * (1.0 / 120 + r2 * (-1.0 / 5040 + r2 * (1.0 / 362880 + r2 * (-1.0 / 39916800 + r2 * (1.0 / 6227020800.0)))))));
        const double cc = 1.0 + r2 * (-0.5 + r2 * (1.0 / 24 + r2 * (-1.0 / 720 + r2 * (1.0 / 40320 + r2 * (-1.0 / 3628800 + r2 * (1.0 / 479001600.0 + r2 * (-1.0 / 87178291200.0)))))));
        double co, si;
        switch (q & 3) { case 0: co = cc; si = s; break; case 1: co = -s; si = cc; break; case 2: co = -cc; si = -s; break; default: co = s; si = -cc; break; }
        rope[e] = (f32x2){(float)co, (float)si};
    }
    LAS float* scr = (LAS float*)(lds + wave * 8448);
    const int gw = blockIdx.x * 8 + wave, NGW = G * 8;
    constexpr int I_IN = 32 * 96, I_INV = 32 * 32, I_UQ = 8 * 48, I_KVK = 4 * 32, I_KVV = 4 * 32, I_OUT = 32 * 64, I_1 = 32 * 256, I_2 = 128 * 64;
    constexpr int PER_L = I_IN + I_INV + I_UQ + I_KVK + I_KVV + I_OUT + I_1 + I_2;
    for (int it = gw; it < 2 * PER_L; it += NGW) {
        const int l = it / PER_L; int r = it % PER_L;
        if (r < I_1) { transpose_item(A.w_ff1 + (size_t)l * DM * DFF, DM, DFF, (bf16_t*)(ws + WS_W1) + (size_t)l * DFF * DM, 5, nullptr, scr, r, 256, lane); continue; } r -= I_1;
        if (r < I_2) { transpose_item(A.w_ff2 + (size_t)l * DFF * DM, DFF, DM, (bf16_t*)(ws + WS_W2) + (size_t)l * DM * DFF, 5, nullptr, scr, r, 64, lane); continue; } r -= I_2;
        if (r < I_IN) { transpose_item(A.w_in + (size_t)l * DM * INW, DM, INW, (bf16_t*)(ws + WS_WIN) + (size_t)l * 3072 * DM, 0, nullptr, scr, r, 96, lane); continue; } r -= I_IN;
        if (r < I_OUT) { transpose_item(A.w_out + (size_t)l * DM * DM, DM, DM, (bf16_t*)(ws + WS_WOUT) + (size_t)l * DM * DM, 5, nullptr, scr, r, 64, lane); continue; } r -= I_OUT;
        if (r < I_INV) { transpose_item(A.w_in + (size_t)l * DM * INW, DM, INW, (bf16_t*)(ws + WS_WINV) + (size_t)l * 1024 * DM, 1, nullptr, scr, r, 32, lane); continue; } r -= I_INV;
        if (r < I_UQ) { transpose_item(A.w_uq + (size_t)l * 512 * 1536, 512, 1536, (bf16_t*)(ws + WS_WUQ) + (size_t)l * 1536 * 512, 2, A.q_norm + l * 512, scr, r, 48, lane); continue; } r -= I_UQ;
        if (r < I_KVK) { transpose_item(A.w_ukv + (size_t)l * 256 * 2048, 256, 2048, (bf16_t*)(ws + WS_WUKVK) + (size_t)l * 1024 * 256, 3, A.kv_norm + l * 256, scr, r, 32, lane); continue; } r -= I_KVK;
        transpose_item(A.w_ukv + (size_t)l * 256 * 2048, 256, 2048, (bf16_t*)(ws + WS_WUKVV) + (size_t)l * 1024 * 256, 4, A.kv_norm + l * 256, scr, r, 32, lane);
    }
}

__device__ __forceinline__ void norm_mod_phase(const float* __restrict__ X, const float* __restrict__ g, const float* __restrict__ sh, const float* __restrict__ sc, bf16_t* __restrict__ H, int G, const int wv) {
    const int tid = opaque_tid(wv), lane = tid & 63, gw = blockIdx.x * 8 + (tid >> 6), NGW = G * 8;
    for (int row = gw; row < MTOK; row += NGW) {
        const int bb = row >> 11;
        const f32x4* xr = (const f32x4*)(X + (size_t)row * DM) + lane;
        f32x4 v[8]; float ss = 0.f;
#pragma unroll
        for (int j = 0; j < 8; ++j) { v[j] = xr[64 * j]; ss += (v[j][0] * v[j][0] + v[j][1] * v[j][1]) + (v[j][2] * v[j][2] + v[j][3] * v[j][3]); }
        const float rinv = 1.0f / sqrtf(wave_sum(ss, lane) * (1.0f / DM) + EPS);
        u32x2* op = (u32x2*)(H + (size_t)row * DM) + lane;
#pragma unroll
        for (int j = 0; j < 8; ++j) { const int c = (lane + 64 * j) * 4;
            const f32x4 gg = *(const f32x4*)(g + c), s1 = *(const f32x4*)(sc + (size_t)bb * ADAW + c), s0 = *(const f32x4*)(sh + (size_t)bb * ADAW + c);
            const f32x4 y = v[j] * rinv * gg * (s1 + 1.0f) + s0;
            u32x2 w; w.x = cvt_pk_bf16(y[0], y[1]); w.y = cvt_pk_bf16(y[2], y[3]); op[64 * j] = w; }
    }
}
__device__ __forceinline__ void fcumsum_task(const float* __restrict__ LOGF, float* __restrict__ NF2, int bh, int lane) {
    const int bb = bh >> 3, h = bh & 7;
    const float* src = LOGF + ((size_t)bb * SEQ + 32 * lane) * 8 + h;
    float v[32]; float tot = 0.f;
#pragma unroll
    for (int i = 0; i < 32; ++i) { tot += src[(size_t)i * 8]; v[i] = tot; }
    float inc = tot;
#pragma unroll
    for (int o = 1; o < 64; o <<= 1) { const float t = __builtin_bit_cast(float, __builtin_amdgcn_ds_bpermute(((lane - o) & 63) << 2, __builtin_bit_cast(int, inc))); if (lane >= o) inc += t; }
    const float excl = inc - tot;
    float* dst = NF2 + (size_t)bh * SEQ + 32 * lane;
#pragma unroll
    for (int i = 0; i < 32; ++i) dst[i] = -(excl + v[i]) * LOG2E;
}

constexpr int N_PHASES = 17;
__global__ void __launch_bounds__(512) fwd_megakernel(Args A) {
    extern __shared__ __attribute__((aligned(16))) unsigned char lds_raw[];
    LAS unsigned char* lds = (LAS unsigned char*)lds_raw;
    const int G = gridDim.x, bx = blockIdx.x;
    const int wv = __builtin_amdgcn_readfirstlane((int)threadIdx.x >> 6);
    unsigned char* ws = A.ws;
    const int lo = A.ph_lo, hi = A.ph_hi;
#if MK_MULTI
#define SEAM(k) do { } while (0)
#else
    cg::grid_group grid = cg::this_grid();
    unsigned* xbar = (unsigned*)(ws + WS_CTL) + 1024;
    volatile LAS unsigned* xst = (volatile LAS unsigned*)(lds + MISC_OFF + 64);
    { const int t0_ = opaque_tid(wv); if (t0_ == 0) { xst[0] = 0u; xst[1] = 0u; (void)xb_add(&xbar[XB_XCNT(xb_xcc_id())], 1u); } }
#define SEAM(k) do { if (lo <= (k) && (k) + 1 < hi) { if (hi > 1000) grid.sync(); else xcd_barrier(xbar, xst, opaque_tid(wv) == 0); } } while (0)
#endif
#ifndef PHMASK
#define PHMASK 0x3ff
#endif
#define EN(t) ((PHMASK >> (t)) & 1)
#ifndef REPMASK
#define REPMASK 0
#endif
#define NREP(t) (((REPMASK >> (t)) & 1) ? 2 : 1)
#define IN(k) (lo <= (k) && (k) < hi)
    float* mod = (float*)(ws + WS_MOD);
    const f32x2* rope = (const f32x2*)(ws + WS_ROPE);
    bf16_t* Hb = (bf16_t*)(ws + WS_H);
    float* Xb = (float*)(ws + WS_X);

    if (EN(0) && IN(0)) {
        prologue_phase(A, lds, G, wv);
        if (opaque_tid(wv) == 0) { unsigned sp = 0u; while (__hip_atomic_load((unsigned*)(ws + WS_CTL) + 4, __ATOMIC_RELAXED, __HIP_MEMORY_SCOPE_AGENT) < 384u && ++sp < (1u << 22)) __builtin_amdgcn_s_sleep(2); }
        __syncthreads();
        __builtin_amdgcn_fence(__ATOMIC_ACQUIRE, "agent");
        norm_mod_phase(A.x, A.norm_mix, mod, mod + DM, Hb, G, wv);
        SEAM(0);
    }

    for (int l = 0; l < 2; ++l) {
        const int P = 1 + 8 * l;
        const float* modl = mod + (size_t)l * 4 * ADAW;
        const float* Xin = (l == 0) ? A.x : Xb;
        if (EN(2) && IN(P + 1)) {
            {
              pg8::Gemm g{Hb, (const bf16_t*)(ws + WS_WIN) + (size_t)l * 3072 * DM, MTOK, 3072, DM};
              pg8::Gemm g2{(const bf16_t*)(ws + WS_WINV) + (size_t)l * 1024 * DM, Hb, 1024, MTOK, DM};
              pg8::TwoOrders S; S.init(MTOK, 3072, bx, 1024, MTOK, (bx + 128) % G, G);
              EpiInBoth E{EpiIn{(bf16_t*)(ws + WS_CQ), (bf16_t*)(ws + WS_CKV), (bf16_t*)(ws + WS_KR), (bf16_t*)(ws + WS_QK4), (float*)(ws + WS_SSQQ), (float*)(ws + WS_SSQKV), (float*)(ws + WS_LOGF), rope, A.b_forget + l * 8},
                          EpiPlain{(bf16_t*)(ws + WS_VTS), MTOK, 0, 1}};
              pg8::gemm_phase(lds, g, S, E, wv, g2); }
            SEAM(P + 1);
        }
        if (EN(3) && IN(P + 2)) {
            for (int rp_ = 0; rp_ < NREP(3); ++rp_) {
#ifndef P3SEL
#define P3SEL 15
#endif
            if (P3SEL & 1) { const int t_ = opaque_tid(wv); if (bx < 32 && (t_ >> 6) == 0) fcumsum_task((const float*)(ws + WS_LOGF), (float*)(ws + WS_NF2), bx, t_ & 63); }
            if (P3SEL & 2) { pg8::Gemm g{(const bf16_t*)(ws + WS_CQ), (const bf16_t*)(ws + WS_WUQ) + (size_t)l * 1536 * 512, MTOK, 1536, 512}; pg8::StaticOrder S; S.init(MTOK, 1536, G, bx);
              EpiUq E{(bf16_t*)(ws + WS_QM), (const float*)(ws + WS_SSQQ), rope};
              pg8::gemm_phase(lds, g, S, E, wv); }
            if (P3SEL & 4) { pg8::Gemm g{(const bf16_t*)(ws + WS_CKV), (const bf16_t*)(ws + WS_WUKVK) + (size_t)l * 1024 * 256, MTOK, 1024, 256}; pg8::StaticOrder S; S.init(MTOK, 1024, G, (bx + 64) % G);
              EpiKn E{(bf16_t*)(ws + WS_KN), (const float*)(ws + WS_SSQKV)};
              pg8::gemm_phase(lds, g, S, E, wv); }
            if (P3SEL & 8) { const int c2 = (bx >= 192) ? (bx + 64) % G : ((bx >= 64 && bx < 128) ? bx : G - 1);
              pg8::Gemm g{(const bf16_t*)(ws + WS_WUKVV) + (size_t)l * 1024 * 256, (const bf16_t*)(ws + WS_CKV), 1024, MTOK, 256}; pg8::StaticOrder S; S.init(1024, MTOK, G, G == 256 ? c2 : bx);
              EpiVtm E{(bf16_t*)(ws + WS_VTM), (const float*)(ws + WS_SSQKV)};
              pg8::gemm_phase(lds, g, S, E, wv); }
            }
            SEAM(P + 2);
        }
        if (EN(4) && IN(P + 3)) {
            unsigned* ctr = (unsigned*)(ws + WS_CTL) + 64 * l;
            volatile LAS int* qslot = (volatile LAS int*)(lds + MISC_OFF);
            const bf16_t* QK4 = (const bf16_t*)(ws + WS_QK4); const size_t QS = (size_t)MTOK * 512;
            const float* gout = A.out_norm + l * DM;
#ifndef ATT_DYNQ
#define ATT_DYNQ 1
#endif
            for (int ui_ = 0;; ++ui_) {
                int idx;
                if (ATT_DYNQ) {
                    if (ui_ == 0) idx = bx;
                    else {
                        if (opaque_tid(wv) == 0) *qslot = G + (int)atomicAdd(ctr, 1u);
                        __syncthreads();
                        idx = *qslot;
                        __syncthreads();
                    }
                } else {
                    idx = (ui_ == 1) ? (511 - bx) : (ui_ * 256 + bx);
                    if (ui_ >= 3 || G != 256) idx = 768;
                }
                if (idx >= 768) break;
                const int code = att_code(idx >> 5), bh = idx & 31, type = code >> 3, qb = code & 7, bb = bh >> 3, h = bh & 7;
                if (type == 0) attn_unit<0>(bb, h, qb, (const bf16_t*)(ws + WS_QM), (const bf16_t*)(ws + WS_KN), (const bf16_t*)(ws + WS_KR), (const bf16_t*)(ws + WS_VTM), nullptr, gout, (bf16_t*)(ws + WS_OB), lds, wv);
                else if (type == 1) attn_unit<1>(bb, h, qb, QK4, QK4 + QS, nullptr, (const bf16_t*)(ws + WS_VTS), nullptr, gout, (bf16_t*)(ws + WS_OB), lds, wv);
                else attn_unit<2>(bb, h, qb, QK4 + 2 * QS, QK4 + 3 * QS, nullptr, (const bf16_t*)(ws + WS_VTS) + (size_t)512 * MTOK, (const float*)(ws + WS_NF2), gout, (bf16_t*)(ws + WS_OB), lds, wv);
            }
            SEAM(P + 3);
        }
        if (EN(5) && IN(P + 4)) {
            pg8::Gemm g{(const bf16_t*)(ws + WS_OB), (const bf16_t*)(ws + WS_WOUT) + (size_t)l * DM * DM, MTOK, DM, DM}; pg8::StaticOrder S; S.init(MTOK, DM, G, bx);
            EpiResNorm E{Xin, Xb, modl + 2 * DM, A.norm_ffn + l * DM, modl + 3 * DM, modl + 4 * DM, Hb, nullptr, 0,
                         (float*)(ws + WS_XCH) + (size_t)(2 * l) * MTOK * 8, (unsigned*)(ws + WS_CTL) + 8192 + (2 * l) * 2048, (unsigned*)(ws + WS_CTL) + 2};
            pg8::gemm_phase(lds, g, S, E, wv);
            SEAM(P + 4);
        }
        if (EN(7) && IN(P + 6)) {
            pg8::Gemm g{Hb, (const bf16_t*)(ws + WS_W1) + (size_t)l * DFF * DM, MTOK, DFF, DM}; pg8::StaticOrder S; S.init(MTOK, DFF, G, bx);
            EpiPlain E{(bf16_t*)(ws + WS_HB), DFF, 1, 0};
            for (int rp_ = 0; rp_ < NREP(7); ++rp_) pg8::gemm_phase(lds, g, S, E, wv);
            SEAM(P + 6);
        }
        if (EN(8) && IN(P + 7)) {
            pg8::Gemm g{(const bf16_t*)(ws + WS_HB), (const bf16_t*)(ws + WS_W2) + (size_t)l * DM * DFF, MTOK, DM, DFF}; pg8::StaticOrder S; S.init(MTOK, DM, G, bx);
            const float* mod1 = mod + (size_t)4 * ADAW;
            EpiResNorm E{Xb, (l == 0) ? Xb : nullptr, modl + 5 * DM, (l == 0) ? A.norm_mix + DM : A.final_norm, mod1 + 0 * DM, mod1 + 1 * DM, Hb, A.out, (l == 0) ? 0 : 1,
                         (float*)(ws + WS_XCH) + (size_t)(2 * l + 1) * MTOK * 8, (unsigned*)(ws + WS_CTL) + 8192 + (2 * l + 1) * 2048, (unsigned*)(ws + WS_CTL) + 2};
            pg8::gemm_phase(lds, g, S, E, wv);
            SEAM(P + 7);
        }
    }
#undef IN
#undef SEAM
}

extern "C" void kernel_launch(void* const* d_in, const int* in_sizes, int n_in, void* d_out, int out_size, void* d_ws, size_t ws_size, hipStream_t stream) {
    static int grid = 0;
    if (grid == 0) {
        if (n_in != 17 || out_size != MTOK * DM || ws_size < WS_END) { fprintf(stderr, "kernel_launch: unexpected problem (n_in %d out %d ws %zu)\n", n_in, out_size, ws_size); grid = -1; return; }
        int dev = 0, cus = 0, per_cu = 0;
        hipGetDevice(&dev);
        hipDeviceGetAttribute(&cus, hipDeviceAttributeMultiprocessorCount, dev);
        if (hipFuncSetAttribute((const void*)fwd_megakernel, hipFuncAttributeMaxDynamicSharedMemorySize, LDS_BYTES) != hipSuccess) { fprintf(stderr, "kernel_launch: hipFuncSetAttribute failed\n"); grid = -1; return; }
        if (hipOccupancyMaxActiveBlocksPerMultiprocessor(&per_cu, (const void*)fwd_megakernel, 512, LDS_BYTES) != hipSuccess || per_cu < 1) { fprintf(stderr, "kernel_launch: occupancy query says %d\n", per_cu); per_cu = 1; }
        (void)hipGetLastError();
        grid = cus * (per_cu < 1 ? 1 : 1);
        if (grid <= 0) grid = 256;
    }
    if (grid < 0) return;
    hipMemsetAsync((char*)d_ws + WS_CTL, 0, CTL_BYTES, stream);
    Args a{};
    a.x = (const float*)d_in[0]; a.c = (const float*)d_in[1]; a.w_ada = (const float*)d_in[2]; a.b_ada = (const float*)d_in[3]; a.norm_mix = (const float*)d_in[4];
    a.w_in = (const float*)d_in[5]; a.q_norm = (const float*)d_in[6]; a.w_uq = (const float*)d_in[7]; a.kv_norm = (const float*)d_in[8]; a.w_ukv = (const float*)d_in[9];
    a.b_forget = (const float*)d_in[10]; a.out_norm = (const float*)d_in[11]; a.w_out = (const float*)d_in[12]; a.norm_ffn = (const float*)d_in[13];
    a.w_ff1 = (const float*)d_in[14]; a.w_ff2 = (const float*)d_in[15]; a.final_norm = (const float*)d_in[16];
    a.out = (float*)d_out; a.ws = (unsigned char*)d_ws;
#if MK_MULTI
    for (int p = 0; p < N_PHASES; ++p) { a.ph_lo = p; a.ph_hi = p + 1; hipLaunchKernelGGL(fwd_megakernel, dim3(grid), dim3(512), LDS_BYTES, stream, a); }
#else
    a.ph_lo = 0; a.ph_hi = N_PHASES;
    void* args[] = {&a};
    hipError_t e = hipLaunchCooperativeKernel((const void*)fwd_megakernel, dim3(grid), dim3(512), args, LDS_BYTES, stream);
    if (e != hipSuccess) fprintf(stderr, "kernel_launch: cooperative launch failed: %s (grid %d)\n", hipGetErrorString(e), grid);
#endif
}
```

```cpp
#include <hip/hip_runtime.h>
#include <hip/hip_cooperative_groups.h>
#include <cstdio>
#include <cstdint>
namespace cg = cooperative_groups;

#ifndef MK_MULTI
#define MK_MULTI 0
#endif

#define LAS __attribute__((address_space(3)))
typedef unsigned short bf16_t;
typedef short bf16x8 __attribute__((ext_vector_type(8)));
typedef float f32x2 __attribute__((ext_vector_type(2)));
typedef float f32x4 __attribute__((ext_vector_type(4)));
typedef float f32x16 __attribute__((ext_vector_type(16)));
typedef unsigned u32x2 __attribute__((ext_vector_type(2)));
typedef unsigned u32x4 __attribute__((ext_vector_type(4)));

constexpr int DM = 2048, SEQ = 2048, MTOK = 8192, DFF = 8192, INW = 3912, ADAW = 12288;
constexpr float EPS = 1e-6f;
constexpr float LOG2E = 1.4426950408889634f;
constexpr float QSCALE64 = 0.125f * LOG2E;
constexpr float QSCALE192 = 0.07216878364870323f * LOG2E;

constexpr size_t MiB = 1u << 20;
constexpr size_t WS_CTL = 0, CTL_BYTES = 65536;
constexpr size_t WS_XCH = 5 * MiB;
constexpr size_t WS_ROPE = 1 * MiB;
constexpr size_t WS_MOD = 2 * MiB;
constexpr size_t WS_SSQQ = 3 * MiB;
constexpr size_t WS_SSQKV = 3 * MiB + 512 * 1024;
constexpr size_t WS_NF2 = 4 * MiB;
constexpr size_t WS_LOGF = 4 * MiB + 512 * 1024;
constexpr size_t WS_WIN = 8 * MiB;
constexpr size_t WS_WINV = 32 * MiB;
constexpr size_t WS_WUQ = 40 * MiB;
constexpr size_t WS_WUKVK = 43 * MiB;
constexpr size_t WS_WUKVV = 44 * MiB;
constexpr size_t WS_WOUT = 48 * MiB;
constexpr size_t WS_W1 = 64 * MiB;
constexpr size_t WS_W2 = 128 * MiB;
constexpr size_t WS_H = 192 * MiB;
constexpr size_t WS_CQ = 224 * MiB;
constexpr size_t WS_CKV = 232 * MiB;
constexpr size_t WS_KR = 236 * MiB;
constexpr size_t WS_QK4 = 240 * MiB;
constexpr size_t WS_VTS = 272 * MiB;
constexpr size_t WS_QM = 288 * MiB;
constexpr size_t WS_KN = 312 * MiB;
constexpr size_t WS_VTM = 328 * MiB;
constexpr size_t WS_OB = 344 * MiB;
constexpr size_t WS_X = 384 * MiB;
constexpr size_t WS_HB = 448 * MiB;
constexpr size_t WS_END = 576 * MiB;

constexpr int LDS_BYTES = 135168;
constexpr int MISC_OFF = 131072;

__device__ const float INVF[32] = {1.0f, 0.7498942613601685f, 0.5623413324356079f, 0.4216965138912201f, 0.3162277638912201f, 0.23713737726211548f, 0.17782793939113617f, 0.133352130651474f, 0.10000000149011612f, 0.07498941570520401f, 0.05623413249850273f, 0.04216965287923813f, 0.03162277489900589f, 0.023713737726211548f, 0.017782794311642647f, 0.01333521492779255f, 0.009999999776482582f, 0.007498941849917173f, 0.005623413249850273f, 0.0042169648222625256f, 0.003162277629598975f, 0.00237137358635664f, 0.0017782794311642647f, 0.0013335214462131262f, 0.0010000000474974513f, 0.0007498942431993783f, 0.000562341301701963f, 0.0004216965171508491f, 0.0003162277571391314f, 0.00023713737027719617f, 0.00017782794020604342f, 0.0001333521504420787f};
__device__ const unsigned char ATT_ORDER[24] = {7, 6, 5, 15, 23, 14, 4, 22, 13, 3, 21, 12, 20, 2, 11, 19, 10, 1, 18, 9, 17, 0, 8, 16};
__device__ __forceinline__ int att_code(int grp) {
    const unsigned long long w = (grp < 12) ? 0x6546db11d7794c7ull : 0x820114c82a9ac54ull;
    return (int)((w >> (5 * ((grp < 12) ? grp : grp - 12))) & 31ull);
}

typedef __bf16 bf16x2_t __attribute__((ext_vector_type(2)));
__device__ __forceinline__ unsigned cvt_pk_bf16(float lo, float hi) { const f32x2 v = {lo, hi}; const bf16x2_t b = __builtin_convertvector(v, bf16x2_t); return __builtin_bit_cast(unsigned, b); }
__device__ __forceinline__ float shx(float v, int lane, int o) { return __builtin_bit_cast(float, __builtin_amdgcn_ds_bpermute((lane ^ o) << 2, __builtin_bit_cast(int, v))); }
__device__ __forceinline__ float wave_sum(float v, int lane) {
#pragma unroll
    for (int o = 1; o < 64; o <<= 1) v += shx(v, lane, o);
    return v;
}
__device__ __forceinline__ int opaque_tid(int wv) { unsigned z = 0u; asm volatile("" : "+v"(z)); return (wv << 6) | (int)__builtin_amdgcn_mbcnt_hi(~0u, __builtin_amdgcn_mbcnt_lo(~0u, z)); }
__device__ __forceinline__ float fexp2(float x) { return __builtin_amdgcn_exp2f(x); }
__device__ __forceinline__ float flog2(float x) { return __builtin_amdgcn_logf(x); }

namespace pg8 {
constexpr int BM = 256, BK = 64, HALF = 128, HTB = HALF * BK * 2, STAGE_BYTES = 8 * HTB, NXCD = 8, WGM = 4;
__host__ __device__ __forceinline__ int lds_byte(int r, int c) { const int st = (r >> 4) * 2 + (c >> 5), rr = r & 15, cc = c & 31, ob = rr * 64 + cc * 2; return st * 1024 + (ob ^ (((ob >> 9) & 1) << 5)); }
__host__ __device__ __forceinline__ void stage_rc(int b, int& R, int& C) { const int st = b / 1024, sb = b % 1024, swz = sb ^ (((sb >> 9) & 1) << 5); R = (st >> 1) * 16 + swz / 64; C = (st & 1) * 32 + (swz % 64) / 2; }
__host__ __device__ __forceinline__ int perm32(int rho) { const int n = rho >> 4, i = rho & 15; return 8 * (i >> 2) + 4 * n + (i & 3); }
struct Unit { int pm, pn, g; };
struct Gemm { const bf16_t* A; const bf16_t* Bt; int M, N, K; };
struct StaticOrder {
    int nM, nN, nwg, G, c;
    __device__ __forceinline__ void init(int M, int N, int G_, int c_) { nM = M / BM; nN = N / BM; nwg = nM * nN; G = G_; c = c_; }
    __device__ __forceinline__ bool next(int i, Unit& u) const {
        const long L = (long)i * G + c; if (L >= nwg) return false;
        int wgid = (int)L; { const int q = nwg / NXCD, r = nwg % NXCD, xcd = wgid % NXCD, off = wgid / NXCD; wgid = (xcd < r ? xcd * (q + 1) : r * (q + 1) + (xcd - r) * q) + off; }
        const int nig = WGM * nN, gid = wgid / nig, fm = gid * WGM, gsz = (nM - fm) < WGM ? (nM - fm) : WGM;
        u.pm = fm + ((wgid % nig) % gsz); u.pn = (wgid % nig) / gsz; u.g = 0; return true;
    }
};
template <class Epi, class Sched>
__device__ __forceinline__ void gemm_phase(LAS unsigned char* lds, const Gemm g, const Sched& S, const Epi& E, const int wv, const Gemm g2) {
    const int tid = opaque_tid(wv), wid = __builtin_amdgcn_readfirstlane(tid >> 6), lane = tid & 63, wr = wid >> 2, wc = wid & 3, fr = lane & 15, fq = lane >> 4;
    const int K = g.K, nt = K / BK;
    unsigned voffA[2], voffB[2];
#pragma unroll
    for (int i = 0; i < 2; ++i) { int R, C; stage_rc(tid * 16 + i * 8192, R, C); const int Rb = Epi::PERM ? ((R & ~31) + perm32(R & 31)) : R;
        voffA[i] = (unsigned)(R * K + C) * 2u; voffB[i] = (unsigned)(Rb * K + C) * 2u; }
    const size_t kstep = (size_t)(BK * 2);
    const size_t hstep = (size_t)HALF * K * 2;
    const size_t tstep = 2 * hstep;
    const unsigned ldsw = (unsigned)wid * 1024u;
    const int aoff = lds_byte(wr * 64 + fr, fq * 8), boff = lds_byte(wc * 32 + fr, fq * 8);
#define PG8_SA(b, h) (((b) * 2 + (h)) * HTB)
#define PG8_SB(b, h) ((4 + (b) * 2 + (h)) * HTB)
#define PG8_STAGE(bufoff, gbase, voff) do { _Pragma("unroll") for (int _i = 0; _i < 2; ++_i) \
        __builtin_amdgcn_global_load_lds((const unsigned*)((const char*)(gbase) + (voff)[_i]), (LAS unsigned*)(lds + (bufoff) + ldsw + _i * 8192), 16, 0, 0); } while (0)
#define PG8_LDA(dst, b, h) do { _Pragma("unroll") for (int m = 0; m < 4; ++m) _Pragma("unroll") for (int k = 0; k < 2; ++k) dst[m][k] = *(const LAS bf16x8*)(lds + PG8_SA(b, h) + aoff + m * 2048 + k * 1024); } while (0)
#define PG8_LDB(dst, b, h) do { _Pragma("unroll") for (int n = 0; n < 2; ++n) _Pragma("unroll") for (int k = 0; k < 2; ++k) dst[n][k] = *(const LAS bf16x8*)(lds + PG8_SB(b, h) + boff + n * 2048 + k * 1024); } while (0)
#define PG8_MMA(ai, bj, At, Bt) do { __builtin_amdgcn_s_setprio(1); _Pragma("unroll") for (int m = 0; m < 4; ++m) _Pragma("unroll") for (int n = 0; n < 2; ++n) _Pragma("unroll") for (int k = 0; k < 2; ++k) \
        acc[ai][bj][m][n] = __builtin_amdgcn_mfma_f32_16x16x32_bf16(Bt[n][k], At[m][k], acc[ai][bj][m][n], 0, 0, 0); __builtin_amdgcn_s_setprio(0); } while (0)
#define PG8_WAIT_V(n) asm volatile("s_waitcnt vmcnt(" #n ")" ::: "memory")
#define PG8_WAIT_L(n) asm volatile("s_waitcnt lgkmcnt(" #n ")" ::: "memory")
#define PG8_BAR __builtin_amdgcn_s_barrier()
#define PG8_SCHED __builtin_amdgcn_sched_barrier(0)
    Unit cur, nxt; int ui = 0;
    if (!S.next(0, cur)) return;
    f32x4 acc[2][2][4][2];
#pragma unroll
    for (int a = 0; a < 2; ++a)
#pragma unroll
        for (int b = 0; b < 2; ++b)
#pragma unroll
            for (int m = 0; m < 4; ++m)
#pragma unroll
                for (int n = 0; n < 2; ++n) acc[a][b][m][n] = (f32x4){0.f, 0.f, 0.f, 0.f};
    bf16x8 At[4][2], B0[2][2], B1[2][2];
    const char* cA = (const char*)(cur.g ? g2.A : g.A) + (size_t)cur.pm * tstep; const char* cB = (const char*)(cur.g ? g2.Bt : g.Bt) + (size_t)cur.pn * tstep;
    PG8_STAGE(PG8_SB(0, 0), cB, voffB); PG8_STAGE(PG8_SB(0, 1), cB + hstep, voffB); PG8_STAGE(PG8_SA(0, 0), cA, voffA); PG8_STAGE(PG8_SA(0, 1), cA + hstep, voffA);
    if (wr == 1) PG8_BAR;
    PG8_WAIT_V(2); PG8_BAR;
    PG8_STAGE(PG8_SB(1, 0), cB + kstep, voffB); PG8_STAGE(PG8_SA(1, 0), cA + kstep, voffA); PG8_STAGE(PG8_SB(1, 1), cB + hstep + kstep, voffB);
    PG8_WAIT_V(6); PG8_BAR;
    for (;;) {
        const bool has_next = S.next(ui + 1, nxt);
        const char* nA = has_next ? (const char*)(nxt.g ? g2.A : g.A) + (size_t)nxt.pm * tstep : cA; const char* nB = has_next ? (const char*)(nxt.g ? g2.Bt : g.Bt) + (size_t)nxt.pn * tstep : cB;
        const int tend = has_next ? nt : nt - 2;
        for (int t = 0; t < tend; t += 2) {
            const bool last = (t == nt - 2);
            const char* a1 = cA + (size_t)(t + 1) * kstep;
            const char* a2 = last ? nA : cA + (size_t)(t + 2) * kstep; const char* b2 = last ? nB : cB + (size_t)(t + 2) * kstep;
            const char* a3 = a2 + kstep; const char* b3 = b2 + kstep;
            PG8_LDB(B0, 0, 0); PG8_LDB(B1, 0, 1); PG8_SCHED; PG8_LDA(At, 0, 0); PG8_STAGE(PG8_SA(1, 1), a1 + hstep, voffA);
            PG8_WAIT_V(8); PG8_WAIT_L(0); PG8_BAR; PG8_MMA(0, 0, At, B0); PG8_MMA(0, 1, At, B1); PG8_BAR; PG8_SCHED;
            PG8_LDA(At, 0, 1); PG8_STAGE(PG8_SB(0, 0), b2, voffB); PG8_STAGE(PG8_SB(0, 1), b2 + hstep, voffB); PG8_STAGE(PG8_SA(0, 0), a2, voffA);
            PG8_WAIT_V(8); PG8_WAIT_L(0); PG8_BAR; PG8_MMA(1, 0, At, B0); PG8_MMA(1, 1, At, B1); PG8_BAR; PG8_SCHED;
            PG8_LDB(B0, 1, 0); PG8_LDB(B1, 1, 1); PG8_SCHED; PG8_LDA(At, 1, 0); PG8_STAGE(PG8_SA(0, 1), a2 + hstep, voffA);
            PG8_WAIT_V(8); PG8_WAIT_L(0); PG8_BAR; PG8_MMA(0, 0, At, B0); PG8_MMA(0, 1, At, B1); PG8_BAR; PG8_SCHED;
            PG8_LDA(At, 1, 1); PG8_STAGE(PG8_SB(1, 0), b3, voffB); PG8_STAGE(PG8_SB(1, 1), b3 + hstep, voffB); PG8_STAGE(PG8_SA(1, 0), a3, voffA);
            PG8_WAIT_V(8); PG8_WAIT_L(0); PG8_BAR; PG8_MMA(1, 0, At, B0); PG8_MMA(1, 1, At, B1); PG8_BAR; PG8_SCHED;
        }
        if (!has_next) {
            const char* a1 = cA + (size_t)(nt - 1) * kstep;
            PG8_LDB(B0, 0, 0); PG8_LDB(B1, 0, 1); PG8_SCHED; PG8_LDA(At, 0, 0); PG8_STAGE(PG8_SA(1, 1), a1 + hstep, voffA);
            PG8_WAIT_V(8); PG8_WAIT_L(0); PG8_BAR; PG8_MMA(0, 0, At, B0); PG8_MMA(0, 1, At, B1); PG8_BAR; PG8_SCHED;
            PG8_LDA(At, 0, 1);
            PG8_WAIT_V(2); PG8_WAIT_L(0); PG8_BAR; PG8_MMA(1, 0, At, B0); PG8_MMA(1, 1, At, B1); PG8_BAR; PG8_SCHED;
            PG8_LDB(B0, 1, 0); PG8_LDB(B1, 1, 1); PG8_SCHED; PG8_LDA(At, 1, 0);
            PG8_WAIT_V(0); PG8_WAIT_L(0); PG8_BAR; PG8_MMA(0, 0, At, B0); PG8_MMA(0, 1, At, B1); PG8_BAR; PG8_SCHED;
            PG8_LDA(At, 1, 1);
            PG8_WAIT_L(0); PG8_BAR; PG8_MMA(1, 0, At, B0); PG8_MMA(1, 1, At, B1); PG8_BAR; PG8_SCHED;
        }
        if (wr == 0) PG8_BAR;
        if constexpr (!Epi::AFTER_DRAIN) { const int t2_ = opaque_tid(wv), w2_ = __builtin_amdgcn_readfirstlane(t2_ >> 6), l2_ = t2_ & 63; E(acc, cur, w2_ >> 2, w2_ & 3, l2_ & 15, l2_ >> 4); }
        if (!has_next) break;
#pragma unroll
        for (int a = 0; a < 2; ++a)
#pragma unroll
            for (int b = 0; b < 2; ++b)
#pragma unroll
                for (int m = 0; m < 4; ++m)
#pragma unroll
                    for (int n = 0; n < 2; ++n) acc[a][b][m][n] = (f32x4){0.f, 0.f, 0.f, 0.f};
        cur = nxt; cA = nA; cB = nB; ++ui;
        if (wr == 1) PG8_BAR;
    }
    PG8_WAIT_V(0);
    PG8_BAR;
    if constexpr (Epi::AFTER_DRAIN) { const int t2_ = opaque_tid(wv), w2_ = __builtin_amdgcn_readfirstlane(t2_ >> 6), l2_ = t2_ & 63; E.fused(acc, cur, w2_ >> 2, w2_ & 3, l2_ & 15, l2_ >> 4, lds, w2_, l2_); }
#undef PG8_SA
#undef PG8_SB
#undef PG8_STAGE
#undef PG8_LDA
#undef PG8_LDB
#undef PG8_MMA
#undef PG8_WAIT_V
#undef PG8_WAIT_L
#undef PG8_BAR
#undef PG8_SCHED
}
template <class Epi, class Sched>
__device__ __forceinline__ void gemm_phase(LAS unsigned char* lds, const Gemm g, const Sched& S, const Epi& E, const int wv) { gemm_phase(lds, g, S, E, wv, g); }
struct TwoOrders {
    StaticOrder s0, s1; int n0;
    __device__ __forceinline__ void init(int M0, int N0, int c0, int M1, int N1, int c1, int G) { s0.init(M0, N0, G, c0); s1.init(M1, N1, G, c1); n0 = (c0 < s0.nwg) ? (s0.nwg - c0 + G - 1) / G : 0; }
    __device__ __forceinline__ bool next(int i, Unit& u) const {
        if (i < n0) { (void)s0.next(i, u); u.g = 0; return true; }
        if (s1.next(i - n0, u)) { u.g = 1; return true; }
        return false;
    }
};
}
using pg8::Unit;

__device__ __forceinline__ void store8(bf16_t* p, const f32x4 v0, const f32x4 v1) {
    u32x4 w; w.x = cvt_pk_bf16(v0[0], v0[1]); w.y = cvt_pk_bf16(v0[2], v0[3]); w.z = cvt_pk_bf16(v1[0], v1[1]); w.w = cvt_pk_bf16(v1[2], v1[3]);
    *(u32x4*)p = w;
}
__device__ __forceinline__ void store8_perm16(bf16_t* rowp, int c0, const f32x4 v0, const f32x4 v1) {
    const int p0 = (c0 & ~15) + ((c0 & 15) >> 1);
    u32x2 a, b; a.x = cvt_pk_bf16(v0[0], v0[1]); a.y = cvt_pk_bf16(v0[2], v0[3]); b.x = cvt_pk_bf16(v1[0], v1[1]); b.y = cvt_pk_bf16(v1[2], v1[3]);
    *(u32x2*)(rowp + p0) = a; *(u32x2*)(rowp + p0 + 8) = b;
}
__device__ __forceinline__ void rope8(f32x4& v0, f32x4& v1, const f32x2* rope, int pos, int i0) {
    const f32x4 a = *(const f32x4*)(rope + pos * 32 + i0), b = *(const f32x4*)(rope + pos * 32 + i0 + 2);
    f32x4 o0, o1;
    o0[0] = v0[0] * a[0] - v0[1] * a[1]; o0[1] = v0[1] * a[0] + v0[0] * a[1];
    o0[2] = v0[2] * a[2] - v0[3] * a[3]; o0[3] = v0[3] * a[2] + v0[2] * a[3];
    o1[0] = v1[0] * b[0] - v1[1] * b[1]; o1[1] = v1[1] * b[0] + v1[0] * b[1];
    o1[2] = v1[2] * b[2] - v1[3] * b[3]; o1[3] = v1[3] * b[2] + v1[2] * b[3];
    v0 = o0; v1 = o1;
}
__device__ __forceinline__ float log_sigmoid_f(float x) { return fminf(x, 0.f) - 0.6931471805599453f * flog2(1.0f + fexp2(-1.4426950408889634f * fabsf(x))); }

struct EpiIn {
    static constexpr bool PERM = true, AFTER_DRAIN = false;
    bf16_t *CQ, *CKV, *KR, *QK4; float *SSQQ, *SSQKV, *LOGF; const f32x2* rope; const float* bforget;
    __device__ __forceinline__ void operator()(const f32x4 (&acc)[2][2][4][2], const Unit& u, int wr, int wc, int fr, int fq) const {
        const int pn = u.pn, row0 = u.pm * 256 + wr * 64 + fr;
        if (pn < 11) {
            bf16_t* base; int ld, col0; float sc = 1.f; float* ssq = nullptr;
            if (pn < 2) { base = CQ; ld = 512; col0 = pn * 256; ssq = SSQQ + (size_t)(pn * 4 + wc) * MTOK; }
            else if (pn == 2) { base = CKV; ld = 256; col0 = 0; ssq = SSQKV + (size_t)wc * MTOK; }
            else { const int t = pn - 3; base = QK4 + (size_t)(t >> 1) * ((size_t)MTOK * 512); ld = 512; col0 = (t & 1) * 256; if (((t >> 1) & 1) == 0) sc = QSCALE64; }
            col0 += wc * 32 + 8 * fq;
#pragma unroll
            for (int ai = 0; ai < 2; ++ai)
#pragma unroll
                for (int m = 0; m < 4; ++m) {
                    const int row = row0 + ai * 128 + m * 16; float s = 0.f;
#pragma unroll
                    for (int bj = 0; bj < 2; ++bj) {
                        const f32x4 v0 = acc[ai][bj][m][0] * sc, v1 = acc[ai][bj][m][1] * sc;
                        s += (v0[0] * v0[0] + v0[1] * v0[1]) + (v0[2] * v0[2] + v0[3] * v0[3]) + (v1[0] * v1[0] + v1[1] * v1[1]) + (v1[2] * v1[2] + v1[3] * v1[3]);
                        store8(base + (size_t)row * ld + col0 + bj * 128, v0, v1);
                    }
                    if (ssq) { const int ln_ = fr + 16 * fq; s += shx(s, ln_, 16); s += shx(s, ln_, 32); if (fq == 0) ssq[row] = s; }
                }
        } else {
            const int cl0 = wc * 32 + 8 * fq;
            if (wc < 2) {
#pragma unroll
                for (int ai = 0; ai < 2; ++ai)
#pragma unroll
                    for (int m = 0; m < 4; ++m) {
                        const int row = row0 + ai * 128 + m * 16;
                        f32x4 v0 = acc[ai][0][m][0], v1 = acc[ai][0][m][1];
                        rope8(v0, v1, rope, row & (SEQ - 1), cl0 >> 1);
                        store8(KR + (size_t)row * 64 + cl0, v0, v1);
                        asm volatile("" ::: "memory");
                    }
            } else if (wc == 2 && fq == 0) {
                const f32x4 b0 = *(const f32x4*)(bforget), b1 = *(const f32x4*)(bforget + 4);
#pragma unroll
                for (int ai = 0; ai < 2; ++ai)
#pragma unroll
                    for (int m = 0; m < 4; ++m) {
                        const int row = row0 + ai * 128 + m * 16;
                        const f32x4 x0 = acc[ai][0][m][0] + b0, x1 = acc[ai][0][m][1] + b1; f32x4 l0, l1;
#pragma unroll
                        for (int c = 0; c < 4; ++c) { l0[c] = log_sigmoid_f(x0[c]); l1[c] = log_sigmoid_f(x1[c]); }
                        *(f32x4*)(LOGF + (size_t)row * 8) = l0; *(f32x4*)(LOGF + (size_t)row * 8 + 4) = l1;
                    }
            }
        }
    }
};
struct EpiPlain {
    static constexpr bool PERM = true, AFTER_DRAIN = false;
    bf16_t* O; int ld; int relu2; int perm16;
    __device__ __forceinline__ void operator()(const f32x4 (&acc)[2][2][4][2], const Unit& u, int wr, int wc, int fr, int fq) const {
        const int row0 = u.pm * 256 + wr * 64 + fr, col0 = u.pn * 256 + wc * 32 + 8 * fq;
#pragma unroll
        for (int ai = 0; ai < 2; ++ai)
#pragma unroll
            for (int m = 0; m < 4; ++m) {
                bf16_t* rowp = O + (size_t)(row0 + ai * 128 + m * 16) * ld + col0;
#pragma unroll
                for (int bj = 0; bj < 2; ++bj) {
                    f32x4 v0 = acc[ai][bj][m][0], v1 = acc[ai][bj][m][1];
                    if (relu2) {
#pragma unroll
                        for (int c = 0; c < 4; ++c) { const float a = fmaxf(v0[c], 0.f), b = fmaxf(v1[c], 0.f); v0[c] = a * a; v1[c] = b * b; }
                    }
                    if (perm16) store8_perm16(rowp - col0, col0 + bj * 128, v0, v1); else store8(rowp + bj * 128, v0, v1);
                }
            }
    }
};
struct EpiInBoth {
    static constexpr bool PERM = true, AFTER_DRAIN = false;
    EpiIn e0; EpiPlain e1;
    __device__ __forceinline__ void operator()(const f32x4 (&acc)[2][2][4][2], const Unit& u, int wr, int wc, int fr, int fq) const {
        if (u.g == 0) e0(acc, u, wr, wc, fr, fq); else e1(acc, u, wr, wc, fr, fq);
    }
};
struct EpiUq {
    static constexpr bool PERM = true, AFTER_DRAIN = false;
    bf16_t* QM; const float* SSQQ; const f32x2* rope;
    __device__ __forceinline__ void operator()(const f32x4 (&acc)[2][2][4][2], const Unit& u, int wr, int wc, int fr, int fq) const {
        const int row0 = u.pm * 256 + wr * 64 + fr, col0 = u.pn * 256 + wc * 32 + 8 * fq;
        float fs[2][4];
#pragma unroll
        for (int ai = 0; ai < 2; ++ai)
#pragma unroll
            for (int m = 0; m < 4; ++m) {
                const int row = row0 + ai * 128 + m * 16; float s = 0.f;
#pragma unroll
                for (int k = 0; k < 8; ++k) s += SSQQ[(size_t)k * MTOK + row];
                fs[ai][m] = QSCALE192 / sqrtf(s * (1.0f / 512.0f) + EPS);
            }
#pragma unroll
        for (int ai = 0; ai < 2; ++ai)
#pragma unroll
            for (int m = 0; m < 4; ++m) {
                const int row = row0 + ai * 128 + m * 16;
                const float f = fs[ai][m];
#pragma unroll
                for (int bj = 0; bj < 2; ++bj) {
                    const int c = col0 + bj * 128, w = c % 192;
                    f32x4 v0 = acc[ai][bj][m][0] * f, v1 = acc[ai][bj][m][1] * f;
                    if (w >= 128) rope8(v0, v1, rope, row & (SEQ - 1), (w - 128) >> 1);
                    store8(QM + (size_t)row * 1536 + c, v0, v1);
                }
                asm volatile("" ::: "memory");
            }
    }
};
struct EpiKn {
    static constexpr bool PERM = true, AFTER_DRAIN = false;
    bf16_t* KN; const float* SSQKV;
    __device__ __forceinline__ void operator()(const f32x4 (&acc)[2][2][4][2], const Unit& u, int wr, int wc, int fr, int fq) const {
        const int row0 = u.pm * 256 + wr * 64 + fr, col0 = u.pn * 256 + wc * 32 + 8 * fq;
        float fs[2][4];
#pragma unroll
        for (int ai = 0; ai < 2; ++ai)
#pragma unroll
            for (int m = 0; m < 4; ++m) {
                const int row = row0 + ai * 128 + m * 16; float s = 0.f;
#pragma unroll
                for (int k = 0; k < 4; ++k) s += SSQKV[(size_t)k * MTOK + row];
                fs[ai][m] = 1.0f / sqrtf(s * (1.0f / 256.0f) + EPS);
            }
#pragma unroll
        for (int ai = 0; ai < 2; ++ai)
#pragma unroll
            for (int m = 0; m < 4; ++m) {
                const int row = row0 + ai * 128 + m * 16;
                const float f = fs[ai][m];
#pragma unroll
                for (int bj = 0; bj < 2; ++bj) store8(KN + (size_t)row * 1024 + col0 + bj * 128, acc[ai][bj][m][0] * f, acc[ai][bj][m][1] * f);
                asm volatile("" ::: "memory");
            }
    }
};
struct EpiVtm {
    static constexpr bool PERM = true, AFTER_DRAIN = false;
    bf16_t* VTM; const float* SSQKV;
    __device__ __forceinline__ void operator()(const f32x4 (&acc)[2][2][4][2], const Unit& u, int wr, int wc, int fr, int fq) const {
        const int row0 = u.pm * 256 + wr * 64 + fr, col0 = u.pn * 256 + wc * 32 + 8 * fq;
#pragma unroll
        for (int bj = 0; bj < 2; ++bj) {
            f32x4 rv[2];
#pragma unroll
            for (int n = 0; n < 2; ++n) {
                const int c = col0 + bj * 128 + 4 * n; f32x4 s = (f32x4){0.f, 0.f, 0.f, 0.f};
#pragma unroll
                for (int k = 0; k < 4; ++k) s += *(const f32x4*)(SSQKV + (size_t)k * MTOK + c);
#pragma unroll
                for (int e = 0; e < 4; ++e) rv[n][e] = 1.0f / sqrtf(s[e] * (1.0f / 256.0f) + EPS);
            }
#pragma unroll
            for (int ai = 0; ai < 2; ++ai)
#pragma unroll
                for (int m = 0; m < 4; ++m) {
                    store8_perm16(VTM + (size_t)(row0 + ai * 128 + m * 16) * MTOK, col0 + bj * 128, acc[ai][bj][m][0] * rv[0], acc[ai][bj][m][1] * rv[1]);
                    asm volatile("" ::: "memory");
                }
        }
    }
};
struct EpiResNorm {
    static constexpr bool PERM = false, AFTER_DRAIN = true;
    const float* Xin; float* Xout; const float* gate; const float* gw; const float* sh; const float* sc; bf16_t* H; float* Fout; int mode;
    float* xbuf; unsigned* cnt; unsigned* tmo;
    __device__ __forceinline__ void fused(f32x4 (&acc)[2][2][4][2], const Unit& u, int wr, int wc, int fr, int fq, LAS unsigned char* lds, int wid, int lane) const {
        LAS float* P = (LAS float*)lds;
        LAS float* S = (LAS float*)(lds + 4096);
        LAS unsigned* flag = (LAS unsigned*)(lds + 4096 + 1024);
        const int row0 = u.pm * 256 + wr * 64 + fr, col0 = u.pn * 256 + wc * 32 + 4 * fq;
        const int bb = u.pm >> 3;
        {
            const float* gp = gate + (size_t)bb * ADAW + col0;
            f32x4 gv[2][2];
#pragma unroll
            for (int bj = 0; bj < 2; ++bj)
#pragma unroll
                for (int n = 0; n < 2; ++n) gv[bj][n] = *(const f32x4*)(gp + bj * 128 + n * 16);
#pragma unroll
            for (int ai = 0; ai < 2; ++ai) {
                f32x4 xi[4][2][2];
#pragma unroll
                for (int m = 0; m < 4; ++m)
#pragma unroll
                    for (int bj = 0; bj < 2; ++bj)
#pragma unroll
                        for (int n = 0; n < 2; ++n) xi[m][bj][n] = *(const f32x4*)(Xin + (size_t)(row0 + ai * 128 + m * 16) * DM + col0 + bj * 128 + n * 16);
#pragma unroll
                for (int m = 0; m < 4; ++m)
#pragma unroll
                    for (int bj = 0; bj < 2; ++bj)
#pragma unroll
                        for (int n = 0; n < 2; ++n) {
                            acc[ai][bj][m][n] = xi[m][bj][n] + gv[bj][n] * acc[ai][bj][m][n];
                            if (Xout) *(f32x4*)(Xout + (size_t)(row0 + ai * 128 + m * 16) * DM + col0 + bj * 128 + n * 16) = acc[ai][bj][m][n];
                        }
#pragma unroll
                for (int m = 0; m < 4; ++m) asm volatile("" : "+v"(acc[ai][0][m][0]), "+v"(acc[ai][0][m][1]), "+v"(acc[ai][1][m][0]), "+v"(acc[ai][1][m][1]));
                asm volatile("" ::: "memory");
            }
        }
#pragma unroll
        for (int ai = 0; ai < 2; ++ai)
#pragma unroll
            for (int m = 0; m < 4; ++m) {
                float q = 0.f;
#pragma unroll
                for (int bj = 0; bj < 2; ++bj)
#pragma unroll
                    for (int n = 0; n < 2; ++n) { const f32x4 x = acc[ai][bj][m][n]; q += (x[0] * x[0] + x[1] * x[1]) + (x[2] * x[2] + x[3] * x[3]); }
                q += shx(q, lane, 16); q += shx(q, lane, 32);
                if (fq == 0) P[(ai * 128 + wr * 64 + m * 16 + fr) * 4 + wc] = q;
            }
        asm volatile("s_waitcnt lgkmcnt(0)" ::: "memory"); __builtin_amdgcn_s_barrier(); asm volatile("" ::: "memory");
        const int row = wid * 32 + (lane & 31);
        if (lane < 32) {
            const f32x4 pp = *(const LAS f32x4*)(P + row * 4);
            const float t = (pp[0] + pp[1]) + (pp[2] + pp[3]);
            __hip_atomic_store(xbuf + (size_t)(u.pm * 256 + row) * 8 + u.pn, t, __ATOMIC_RELAXED, __HIP_MEMORY_SCOPE_AGENT);
        }
        asm volatile("s_waitcnt vmcnt(0)" ::: "memory");
        if (lane == 0) __hip_atomic_fetch_add(cnt + 64 * u.pm, 1u, __ATOMIC_RELAXED, __HIP_MEMORY_SCOPE_AGENT);
        if (wid == 0) {
            unsigned sp = 0u; bool dead = false;
            for (;;) {
                if ((unsigned)__builtin_amdgcn_readfirstlane(__hip_atomic_load(cnt + 64 * u.pm, __ATOMIC_RELAXED, __HIP_MEMORY_SCOPE_AGENT)) >= 64u) break;
                __builtin_amdgcn_s_sleep(2);
                if (++sp > (1u << 22)) { if (lane == 0) __hip_atomic_store(tmo, 1u, __ATOMIC_RELAXED, __HIP_MEMORY_SCOPE_AGENT); dead = true; break; }
            }
            __builtin_amdgcn_fence(__ATOMIC_ACQUIRE, "agent");
            if (lane == 0) flag[0] = dead ? 1u : 0u;
        }
        asm volatile("s_waitcnt vmcnt(0) lgkmcnt(0)" ::: "memory"); __builtin_amdgcn_s_barrier(); asm volatile("" ::: "memory");
        if (lane < 32) {
            const float* slot = xbuf + (size_t)(u.pm * 256 + row) * 8; float t = 0.f;
#pragma unroll
            for (int k = 0; k < 8; ++k) t += __hip_atomic_load(slot + k, __ATOMIC_RELAXED, __HIP_MEMORY_SCOPE_AGENT);
            S[row] = 1.0f / sqrtf(t * (1.0f / DM) + EPS);
        }
        asm volatile("s_waitcnt vmcnt(0) lgkmcnt(0)" ::: "memory"); __builtin_amdgcn_s_barrier(); asm volatile("" ::: "memory");
        {
            f32x4 Av[2][2], Bv[2][2];
#pragma unroll
            for (int bj = 0; bj < 2; ++bj)
#pragma unroll
                for (int n = 0; n < 2; ++n) {
                    const int c = col0 + bj * 128 + n * 16;
                    Av[bj][n] = *(const f32x4*)(gw + c); Bv[bj][n] = (f32x4){0.f, 0.f, 0.f, 0.f};
                    if (mode == 0) { Av[bj][n] = Av[bj][n] * (*(const f32x4*)(sc + (size_t)bb * ADAW + c) + 1.0f); Bv[bj][n] = *(const f32x4*)(sh + (size_t)bb * ADAW + c); }
                }
#pragma unroll
            for (int ai = 0; ai < 2; ++ai)
#pragma unroll
                for (int m = 0; m < 4; ++m) {
                    const int r = ai * 128 + wr * 64 + m * 16 + fr; const float rinv = S[r];
                    const size_t off = (size_t)(u.pm * 256 + r) * DM + col0;
#pragma unroll
                    for (int bj = 0; bj < 2; ++bj)
#pragma unroll
                        for (int n = 0; n < 2; ++n) {
                            const f32x4 y = acc[ai][bj][m][n] * rinv * Av[bj][n] + Bv[bj][n];
                            if (mode == 0) { u32x2 w; w.x = cvt_pk_bf16(y[0], y[1]); w.y = cvt_pk_bf16(y[2], y[3]); *(u32x2*)(H + off + bj * 128 + n * 16) = w; }
                            else *(f32x4*)(Fout + off + bj * 128 + n * 16) = y;
                        }
                }
        }
    }
};

template <int TYPE>
__device__ __forceinline__ void attn_unit(int b, int h, int qb, const bf16_t* __restrict__ Qb, const bf16_t* __restrict__ Kb, const bf16_t* __restrict__ KRb,
                                          const bf16_t* __restrict__ VTb, const float* __restrict__ NF2, const float* __restrict__ gout, bf16_t* __restrict__ OB, LAS unsigned char* lds, const int wv) {
    constexpr int DK = (TYPE == 0) ? 192 : 64, DV = (TYPE == 0) ? 128 : 64;
    constexpr int NQ = DK / 16, NDB = DV / 32;
    constexpr int KN_B = (TYPE == 0) ? 16384 : 8192, KR_B = (TYPE == 0) ? 8192 : 0, VT_B = DV * 128, STG = KN_B + KR_B + VT_B;
    constexpr int KROWB = (TYPE == 0) ? 256 : 128;
    constexpr int BIAS_OFF = 122880;
    constexpr int NI = (TYPE == 0) ? 5 : 2;
    constexpr int LDQ = (TYPE == 0) ? 1536 : 512;
    constexpr int COLOFF = (TYPE == 0) ? 0 : (TYPE == 1 ? 1024 : 1536);
    const int tid = opaque_tid(wv), lane = tid & 63, r32 = lane & 31, hi = lane >> 5;
    const int wid = __builtin_amdgcn_readfirstlane(tid >> 6);
    const int rowbase = b * SEQ, q0 = qb * 256, q0w = q0 + wid * 32;
    const int NT = 4 * (qb + 1), jl = q0w >> 6;

    bf16x8 qf[NQ];
    { const bf16_t* qp = Qb + (size_t)(rowbase + q0w + r32) * LDQ + h * DK + hi * 8;
#pragma unroll
      for (int d0 = 0; d0 < NQ; ++d0) qf[d0] = *(const bf16x8*)(qp + d0 * 16); }
    const int sw = (r32 >> 1) & 7, x15 = r32 & 15;
    int xo[4];
#pragma unroll
    for (int a = 0; a < 4; ++a) xo[a] = ((2 * a + hi) ^ sw) * 16;
    const int kbase = r32 * KROWB, krbase = KN_B + r32 * 128, vbase = KN_B + KR_B + r32 * 128;
    float nfref = 0.f;
    if (TYPE == 2) {
        nfref = NF2[(size_t)(b * 8 + h) * SEQ + q0];
        if (tid * 4 < 256 * (qb + 1)) *(LAS f32x4*)(lds + BIAS_OFF + tid * 16) = *(const f32x4*)(NF2 + (size_t)(b * 8 + h) * SEQ + tid * 4);
    }
    unsigned so0, so1 = 0, so2 = 0, sv0, sv1 = 0;
    if (TYPE == 0) {
        { const int s0 = 64 * (2 * wid) + lane, row = s0 >> 4, ch = (s0 & 15) ^ (row & 15); so0 = (unsigned)((rowbase + row) * 1024 + h * 128 + ch * 8); }
        { const int s1 = 64 * (2 * wid + 1) + lane, row = s1 >> 4, ch = (s1 & 15) ^ (row & 15); so1 = (unsigned)((rowbase + row) * 1024 + h * 128 + ch * 8); }
        { const int s2 = 64 * wid + lane, row = s2 >> 3, ch = (s2 & 7) ^ ((row >> 1) & 7); so2 = (unsigned)((rowbase + row) * 64 + ch * 8); }
        { const int s3 = 64 * (2 * wid) + lane, d = s3 >> 3, c = (s3 & 7) ^ ((d >> 1) & 7); sv0 = (unsigned)((h * 128 + d) * MTOK + rowbase + c * 8); }
        { const int s4 = 64 * (2 * wid + 1) + lane, d = s4 >> 3, c = (s4 & 7) ^ ((d >> 1) & 7); sv1 = (unsigned)((h * 128 + d) * MTOK + rowbase + c * 8); }
    } else {
        { const int s0 = 64 * wid + lane, row = s0 >> 3, ch = (s0 & 7) ^ ((row >> 1) & 7); so0 = (unsigned)((rowbase + row) * 512 + h * 64 + ch * 8); }
        { const int s3 = 64 * wid + lane, d = s3 >> 3, c = (s3 & 7) ^ ((d >> 1) & 7); sv0 = (unsigned)((h * 64 + d) * MTOK + rowbase + c * 8); }
    }
#define ATT_DMA1(gp_, ldsoff_) __builtin_amdgcn_global_load_lds((const unsigned*)(gp_), (LAS unsigned*)(lds + (ldsoff_)), 16, 0, 0)
#define ATT_ISSUE(j, st_) do { const unsigned kj_ = (unsigned)(j) * 64u * ((TYPE == 0) ? 1024u : 512u), vj_ = (unsigned)(j) * 64u; const int sb_ = (st_) * STG; \
        if (TYPE == 0) { ATT_DMA1(Kb + (so0 + kj_), sb_ + (2 * wid) * 1024); ATT_DMA1(Kb + (so1 + kj_), sb_ + (2 * wid + 1) * 1024); ATT_DMA1(KRb + (so2 + (unsigned)(j) * 4096u), sb_ + KN_B + wid * 1024); \
                         ATT_DMA1(VTb + (sv0 + vj_), sb_ + KN_B + KR_B + (2 * wid) * 1024); ATT_DMA1(VTb + (sv1 + vj_), sb_ + KN_B + KR_B + (2 * wid + 1) * 1024); } \
        else { ATT_DMA1(Kb + (so0 + kj_), sb_ + wid * 1024); ATT_DMA1(VTb + (sv0 + vj_), sb_ + KN_B + wid * 1024); } } while (0)

    f32x16 o[NDB];
#pragma unroll
    for (int d = 0; d < NDB; ++d)
#pragma unroll
        for (int r = 0; r < 16; ++r) o[d][r] = 0.f;
    float m_run = -INFINITY, l_run = 0.f, R_run = (TYPE == 1) ? 1.f : 0.f;

    ATT_ISSUE(NT - 1, 0);
    ATT_ISSUE(NT - 2, 1);
    int stg = 0;
    for (int it = 0; it < NT; ++it) {
        const int j = NT - 1 - it, bo = stg * STG;
        if (it + 1 < NT) { if (TYPE == 0) asm volatile("s_waitcnt vmcnt(5) lgkmcnt(0)" ::: "memory"); else asm volatile("s_waitcnt vmcnt(2) lgkmcnt(0)" ::: "memory"); }
        else asm volatile("s_waitcnt vmcnt(0) lgkmcnt(0)" ::: "memory");
        __builtin_amdgcn_s_barrier();
        asm volatile("" ::: "memory");
        if (it + 2 < NT) { const int st2 = (stg == 0) ? 2 : stg - 1; ATT_ISSUE(j - 2, st2); }
        if (j <= jl) {
            f32x16 p0, p1;
            const bool first = (j == jl);
            const float shf = (TYPE == 1 || first) ? 0.f : m_run;
            if (TYPE == 2) {
                const LAS float* bt = (const LAS float*)(lds + BIAS_OFF) + 64 * j;
                const float sub = nfref + shf;
#pragma unroll
                for (int i = 0; i < 8; ++i) { const f32x4 bb = *(const LAS f32x4*)(bt + 8 * i + 4 * hi);
#pragma unroll
                    for (int c = 0; c < 4; ++c) { if (i < 4) p0[4 * i + c] = bb[c] - sub; else p1[4 * (i - 4) + c] = bb[c] - sub; } }
            } else {
#pragma unroll
                for (int r = 0; r < 16; ++r) { p0[r] = -shf; p1[r] = -shf; }
            }
            {
#define ATT_KF(d0_, hh_) (*(const LAS bf16x8*)(lds + bo + (hh_) * 32 * KROWB + ((TYPE == 0) ? (((d0_) < 8) ? (kbase + (((2 * (d0_) + hi) ^ x15) << 4)) : (krbase - (hh_) * 32 * (KROWB - 128) + xo[(d0_) & 3])) : (kbase + xo[(d0_) & 3]))))
                bf16x8 ka[3], kb[3];
                ka[0] = ATT_KF(0, 0); kb[0] = ATT_KF(0, 1); ka[1] = ATT_KF(1, 0); kb[1] = ATT_KF(1, 1);
#pragma unroll
                for (int d0 = 0; d0 < NQ; ++d0) {
                    if (d0 + 2 < NQ) { ka[(d0 + 2) % 3] = ATT_KF(d0 + 2, 0); kb[(d0 + 2) % 3] = ATT_KF(d0 + 2, 1); }
                    __builtin_amdgcn_sched_barrier(0);
                    p0 = __builtin_amdgcn_mfma_f32_32x32x16_bf16(ka[d0 % 3], qf[d0], p0, 0, 0, 0);
                    p1 = __builtin_amdgcn_mfma_f32_32x32x16_bf16(kb[d0 % 3], qf[d0], p1, 0, 0, 0);
                    __builtin_amdgcn_sched_barrier(0);
                }
#undef ATT_KF
            }
            const bool diag = (j == jl);
            float dl_tile = 0.f;
            const int trel = (q0w & 63) + r32;
            if (TYPE == 1) {
                f32x16 B0, B1;
#pragma unroll
                for (int r = 0; r < 16; ++r) {
                    const int kr_ = (r & 3) + 8 * (r >> 2) + 4 * hi;
                    const float z0 = __builtin_amdgcn_fmed3f(p0[r], -80.f, 80.f), z1 = __builtin_amdgcn_fmed3f(p1[r], -80.f, 80.f);
                    const float e0 = fexp2(-z0), e1 = fexp2(-z1);
                    float b0 = __builtin_amdgcn_rcpf(1.0f + e0), b1 = __builtin_amdgcn_rcpf(1.0f + e1);
                    float k0 = e0 * b0, k1 = e1 * b1;
                    if (diag) { if (kr_ >= trel) { b0 = 0.f; k0 = 1.f; } if (kr_ + 32 >= trel) { b1 = 0.f; k1 = 1.f; } }
                    B0[r] = b0; B1[r] = b1; p0[r] = k0; p1[r] = k1;
                }
                float G[8], Go[8];
#pragma unroll
                for (int i = 0; i < 8; ++i) { G[i] = (i < 4) ? ((p0[4 * i] * p0[4 * i + 1]) * (p0[4 * i + 2] * p0[4 * i + 3])) : ((p1[4 * (i - 4)] * p1[4 * (i - 4) + 1]) * (p1[4 * (i - 4) + 2] * p1[4 * (i - 4) + 3]));
                    Go[i] = shx(G[i], lane, 32); }
                float sufp = 1.f;
#pragma unroll
                for (int i = 7; i >= 0; --i) {
                    float w = R_run * sufp * (hi == 0 ? Go[i] : 1.f);
#pragma unroll
                    for (int c = 3; c >= 0; --c) {
                        if (i < 4) { const float kk = p0[4 * i + c]; p0[4 * i + c] = B0[4 * i + c] * w; w *= kk; }
                        else { const float kk = p1[4 * (i - 4) + c]; p1[4 * (i - 4) + c] = B1[4 * (i - 4) + c] * w; w *= kk; }
                    }
                    sufp *= G[i] * Go[i];
                }
                R_run *= sufp;
            } else {
                if (TYPE == 2) { if (diag) {
#pragma unroll
                    for (int r = 0; r < 16; ++r) { const int kr_ = (r & 3) + 8 * (r >> 2) + 4 * hi; if (kr_ > trel) p0[r] = -INFINITY; if (kr_ + 32 > trel) p1[r] = -INFINITY; } } }
                float mx = fmaxf(p0[0], p1[0]);
#pragma unroll
                for (int r = 1; r < 16; ++r) mx = fmaxf(mx, fmaxf(p0[r], p1[r]));
                mx = fmaxf(mx, shx(mx, lane, 32));
                const bool trig = !first && (__builtin_amdgcn_ballot_w64(mx > 8.0f) != 0ull);
                const float dl = first ? mx : (trig ? fmaxf(mx, 0.f) : 0.f);
                const float alpha = first ? 0.f : fexp2(-dl);
                m_run = first ? mx : m_run + dl;
                dl_tile = dl; l_run *= alpha;
                if (trig) {
#pragma unroll
                    for (int d = 0; d < NDB; ++d)
#pragma unroll
                        for (int r = 0; r < 16; ++r) o[d][r] *= alpha;
                }
            }
            {
#define ATT_VF(n_) (*(const LAS bf16x8*)(lds + bo + vbase + ((n_) % NDB) * 4096 + xo[(n_) / NDB]))
                constexpr int NV = 4 * NDB;
                bf16x8 vf[3];
                vf[0] = ATT_VF(0); vf[1] = ATT_VF(1);
                float ls = 0.f;
#pragma unroll
                for (int jp = 0; jp < 4; ++jp) {
                    float e_[8];
#pragma unroll
                    for (int e = 0; e < 8; ++e) { const float x = (jp < 2) ? p0[8 * jp + e] : p1[8 * (jp - 2) + e]; e_[e] = (TYPE == 1) ? x : fexp2(x - dl_tile); }
                    if (TYPE != 1) ls += ((e_[0] + e_[1]) + (e_[2] + e_[3])) + ((e_[4] + e_[5]) + (e_[6] + e_[7]));
                    u32x4 w; w.x = cvt_pk_bf16(e_[0], e_[1]); w.y = cvt_pk_bf16(e_[2], e_[3]); w.z = cvt_pk_bf16(e_[4], e_[5]); w.w = cvt_pk_bf16(e_[6], e_[7]);
                    const bf16x8 pw = __builtin_bit_cast(bf16x8, w);
#pragma unroll
                    for (int d = 0; d < NDB; ++d) {
                        const int n = jp * NDB + d;
                        if (n + 2 < NV) vf[(n + 2) % 3] = ATT_VF(n + 2);
                        __builtin_amdgcn_sched_barrier(0);
                        o[d] = __builtin_amdgcn_mfma_f32_32x32x16_bf16(vf[n % 3], pw, o[d], 0, 0, 0);
                    }
                    __builtin_amdgcn_sched_barrier(0);
                }
                l_run += ls;
#undef ATT_VF
            }
        }
        stg = (stg == 2) ? 0 : stg + 1;
    }
    asm volatile("s_waitcnt lgkmcnt(0)" ::: "memory");
    __builtin_amdgcn_s_barrier();
    asm volatile("" ::: "memory");
#undef ATT_DMA1
#undef ATT_ISSUE
    float inv_l = 1.f;
    if (TYPE != 1) { const float lt = l_run + shx(l_run, lane, 32); inv_l = 1.0f / lt; }
    float ssq = 0.f;
#pragma unroll
    for (int d = 0; d < NDB; ++d)
#pragma unroll
        for (int r = 0; r < 16; ++r) { o[d][r] *= inv_l; ssq += o[d][r] * o[d][r]; }
    ssq += shx(ssq, lane, 32);
    const float rinv = 1.0f / sqrtf(ssq * (1.0f / DV) + EPS);
    constexpr int ROWB = DV * 2 + 16, CH = DV / 8;
    LAS unsigned char* stg_ = lds + wid * (32 * ROWB);
    const float* gp = gout + COLOFF + h * DV + 4 * hi;
#pragma unroll
    for (int d = 0; d < NDB; ++d)
#pragma unroll
        for (int rg = 0; rg < 4; ++rg) {
            const f32x4 g4 = *(const f32x4*)(gp + 32 * d + 8 * rg);
            u32x2 w; w.x = cvt_pk_bf16(o[d][4 * rg] * rinv * g4[0], o[d][4 * rg + 1] * rinv * g4[1]); w.y = cvt_pk_bf16(o[d][4 * rg + 2] * rinv * g4[2], o[d][4 * rg + 3] * rinv * g4[3]);
            *(LAS u32x2*)(stg_ + r32 * ROWB + (32 * d + 8 * rg + 4 * hi) * 2) = w;
        }
    asm volatile("s_waitcnt lgkmcnt(0)" ::: "memory");
    bf16_t* ob = OB + (size_t)(rowbase + q0w) * DM + COLOFF + h * DV;
#pragma unroll
    for (int i = 0; i < CH / 2; ++i) {
        const int row = i * (64 / CH) + lane / CH, ch = lane % CH;
        const u32x4 v = *(const LAS u32x4*)(stg_ + row * ROWB + ch * 16);
        *(u32x4*)(ob + (size_t)row * DM + ch * 8) = v;
    }
}

__device__ __forceinline__ int srccol(int id, int r) {
    if (id == 0) {
        if (r < 768) return r;
        if (r < 1280) return 832 + (r - 768);
        if (r < 1792) return 1344 + (r - 1280);
        if (r < 2304) return 2368 + (r - 1792);
        if (r < 2816) return 2880 + (r - 2304);
        r -= 2816;
        if (r < 64) return 768 + (r >> 1) + (r & 1) * 32;
        if (r < 72) return 3904 + (r - 64);
        return -1;
    }
    if (id == 1) return r < 512 ? 1856 + r : 3392 + (r - 512);
    if (id == 2) { const int h = r / 192, w = r % 192; if (w < 128) return h * 192 + w; const int j = w - 128; return h * 192 + 128 + (j >> 1) + (j & 1) * 32; }
    if (id == 3) return (r >> 7) * 256 + (r & 127);
    if (id == 4) return (r >> 7) * 256 + 128 + (r & 127);
    return r;
}
__device__ __forceinline__ unsigned f2bf(float f) { unsigned u = __builtin_bit_cast(unsigned, f); return (u + 0x7fffu + ((u >> 16) & 1u)) >> 16; }
__device__ __forceinline__ unsigned pk2(float lo, float hi) { return f2bf(lo) | (f2bf(hi) << 16); }
__device__ __forceinline__ void transpose_item(const float* __restrict__ W, int K, int N, bf16_t* __restrict__ WT, int id, const float* __restrict__ gk, LAS float* scr, int item, int nblk, int lane) {
    const int kb = item / nblk, nb = item % nblk, k0 = 64 * kb, n0 = 32 * nb;
    const int sc = srccol(id, n0 + (lane & 31));
    const float* src = W + (size_t)(k0 + (lane >> 5)) * N + (sc < 0 ? 0 : sc);
    float v[32];
#pragma unroll
    for (int i = 0; i < 32; ++i) v[i] = src[(size_t)(2 * i) * N];
    if (sc < 0) {
#pragma unroll
        for (int i = 0; i < 32; ++i) v[i] = 0.f;
    }
    if (gk) {
#pragma unroll
        for (int i = 0; i < 32; ++i) v[i] *= gk[k0 + 2 * i + (lane >> 5)];
    }
#pragma unroll
    for (int i = 0; i < 32; ++i) scr[(2 * i + (lane >> 5)) * 33 + (lane & 31)] = v[i];
    asm volatile("s_waitcnt lgkmcnt(0)" ::: "memory");
    const int c = lane & 7;
#pragma unroll
    for (int j = 0; j < 4; ++j) { const int n = (lane >> 3) + 8 * j; const LAS float* s = scr + (8 * c) * 33 + n;
        u32x4 o; o.x = pk2(s[0 * 33], s[1 * 33]); o.y = pk2(s[2 * 33], s[3 * 33]); o.z = pk2(s[4 * 33], s[5 * 33]); o.w = pk2(s[6 * 33], s[7 * 33]);
        *(u32x4*)(WT + (size_t)(n0 + n) * K + k0 + 8 * c) = o; }
    asm volatile("s_waitcnt lgkmcnt(0)" ::: "memory");
}


#define XB_TMO      128
#define XB_XCNT(j)  (256  + 64 * (j))
#define XB_XSUB(j)  (1280 + 64 * (j))
#define XB_XGEN(j)  (2304 + 64 * (j))
#define XB_TOP      3328
#define XB_TOPGEN   3392
#define XCD_BAR_WORDS 3456
#define XB_SPIN_CAP (1u << 22)
__device__ __forceinline__ unsigned xb_ld(unsigned* p)              { return __hip_atomic_load(p, __ATOMIC_RELAXED, __HIP_MEMORY_SCOPE_AGENT); }
__device__ __forceinline__ unsigned xb_add(unsigned* p, unsigned v) { return __hip_atomic_fetch_add(p, v, __ATOMIC_RELAXED, __HIP_MEMORY_SCOPE_AGENT); }
__device__ __forceinline__ unsigned xb_xcc_id() { return (unsigned)__builtin_amdgcn_s_getreg((3 << 11) | 20) & 0xFu; }
#define XB_SPIN(cond, bar) do { unsigned _sp = 0; while (cond) { __builtin_amdgcn_s_sleep(1); \
    if ((++_sp & 255u) == 0u) { if (xb_ld(&(bar)[XB_TMO])) break; if (_sp > XB_SPIN_CAP) { atomicAdd(&(bar)[XB_TMO], 1u); break; } } } } while (0)
__device__ __forceinline__ void xcd_barrier_complete(unsigned* bar, unsigned x, unsigned& nloc, unsigned& nx) {
    const unsigned G = gridDim.x;
    unsigned sum, cnt, mine, sp = 0u;
    for (;;) {
        sum = 0u; cnt = 0u; mine = 0u;
#pragma unroll
        for (unsigned j = 0; j < 16; ++j) { const unsigned c = xb_ld(&bar[XB_XCNT(j)]); sum += c; cnt += (c > 0u) ? 1u : 0u; mine = (j == x) ? c : mine; }
        if (sum == G) break;
        __builtin_amdgcn_s_sleep(1);
        if ((++sp & 255u) == 0u) { if (xb_ld(&bar[XB_TMO])) break; if (sp > XB_SPIN_CAP) { atomicAdd(&bar[XB_TMO], 1u); break; } }
    }
    nloc = mine > 0u ? mine : 1u; nx = cnt > 0u ? cnt : 1u;
}
__device__ __forceinline__ void xcd_barrier(unsigned* bar, volatile LAS unsigned* st, bool is0) {
    asm volatile("s_waitcnt vmcnt(0)" ::: "memory");
    __syncthreads();
    if (is0) {
        __builtin_amdgcn_s_waitcnt(0);
        const unsigned x = xb_xcc_id();
        unsigned nloc = st[0], nx = st[1];
        if (nloc == 0u) { xcd_barrier_complete(bar, x, nloc, nx); st[0] = nloc; st[1] = nx; }
        const unsigned old = xb_add(&bar[XB_XSUB(x)], 1u);
        const unsigned gen = old / nloc;
        if (old + 1u == (gen + 1u) * nloc) {
            __builtin_amdgcn_fence(__ATOMIC_RELEASE, "agent");
            asm volatile("s_waitcnt vmcnt(0)" ::: "memory");
            const unsigned og = xb_add(&bar[XB_TOP], 1u);
            const unsigned tg = og / nx;
            if (og + 1u == (tg + 1u) * nx) xb_add(&bar[XB_TOPGEN], 1u);
            else XB_SPIN(xb_ld(&bar[XB_TOPGEN]) == tg, bar);
            __builtin_amdgcn_fence(__ATOMIC_ACQUIRE, "agent");
            xb_add(&bar[XB_XGEN(x)], 1u);
            asm volatile("s_waitcnt vmcnt(0)" ::: "memory");
        } else {
            XB_SPIN(xb_ld(&bar[XB_XGEN(x)]) == gen, bar);
            __builtin_amdgcn_fence(__ATOMIC_ACQUIRE, "agent");
            asm volatile("s_waitcnt vmcnt(0)" ::: "memory");
        }
    }
    __syncthreads();
}

struct Args {
    const float *x, *c, *w_ada, *b_ada, *norm_mix, *w_in, *q_norm, *w_uq, *kv_norm, *w_ukv, *b_forget, *out_norm, *w_out, *norm_ffn, *w_ff1, *w_ff2, *final_norm;
    float* out; unsigned char* ws; int ph_lo, ph_hi;
};

__device__ __forceinline__ void prologue_phase(const Args& A, LAS unsigned char* lds, int G, const int wv) {
    const int tid = opaque_tid(wv), lane = tid & 63, wave = __builtin_amdgcn_readfirstlane(tid >> 6);
    unsigned char* ws = A.ws;
    LAS float* cact = (LAS float*)(lds + 69632);
    LAS float* red = (LAS float*)(lds + 102400);
    for (int e = tid; e < 4 * DM; e += 512) { const int bb = e >> 11, k = e & (DM - 1); const float cv = A.c[e]; cact[k * 4 + bb] = cv / (1.0f + expf(-cv)); }
    __syncthreads();
    float* mod = (float*)(ws + WS_MOD);
    for (int t = blockIdx.x; t < 384; t += G) {
        const int l = t / 192, n0 = (t % 192) * 64;
        const float* Wp = A.w_ada + (size_t)l * DM * ADAW + (size_t)(256 * wave) * ADAW + n0 + lane;
        float a0 = 0.f, a1 = 0.f, a2 = 0.f, a3 = 0.f;
#pragma unroll 16
        for (int k = 0; k < 256; ++k) { const float wv = Wp[(size_t)k * ADAW]; const f32x4 ca = *(const LAS f32x4*)(cact + (256 * wave + k) * 4); a0 += ca[0] * wv; a1 += ca[1] * wv; a2 += ca[2] * wv; a3 += ca[3] * wv; }
        red[(wave * 4 + 0) * 64 + lane] = a0; red[(wave * 4 + 1) * 64 + lane] = a1; red[(wave * 4 + 2) * 64 + lane] = a2; red[(wave * 4 + 3) * 64 + lane] = a3;
        __syncthreads();
        if (tid < 256) { const int bb = tid >> 6; float s = 0.f;
#pragma unroll
            for (int w = 0; w < 8; ++w) s += red[(w * 4 + bb) * 64 + lane];
            mod[(size_t)(l * 4 + bb) * ADAW + n0 + lane] = s + A.b_ada[l * ADAW + n0 + lane]; }
        __syncthreads();
        if (tid == 0) { __builtin_amdgcn_fence(__ATOMIC_RELEASE, "agent"); asm volatile("s_waitcnt vmcnt(0)" ::: "memory");
                        __hip_atomic_fetch_add((unsigned*)(ws + WS_CTL) + 4, 1u, __ATOMIC_RELAXED, __HIP_MEMORY_SCOPE_AGENT); }
    }
    f32x2* rope = (f32x2*)(ws + WS_ROPE);
    for (int e = blockIdx.x * 512 + tid; e < SEQ * 32; e += G * 512) {
        const int pos = e >> 5, i = e & 31;
        const double ang = (double)((float)pos * INVF[i]);
        const double n = __builtin_rint(ang * 0.6366197723675814); const int q = (int)n;
        double r = __builtin_fma(-n, 1.5707963267948966, ang); r = __builtin_fma(-n, 6.123233995736766e-17, r);
        const double r2 = r * r;
        const double s = r * (1.0 + r2 * (-1.0 / 6 + r2 * (1.0 / 120 + r2 * (-1.0 / 5040 + r2 * (1.0 / 362880 + r2 * (-1.0 / 39916800 + r2 * (1.0 / 6227020800.0)))))));
        const double cc = 1.0 + r2 * (-0.5 + r2 * (1.0 / 24 + r2 * (-1.0 / 720 + r2 * (1.0 / 40320 + r2 * (-1.0 / 3628800 + r2 * (1.0 / 479001600.0 + r2 * (-1.0 / 87178291200.0)))))));
        double co, si;
        switch (q & 3) { case 0: co = cc; si = s; break; case 1: co = -s; si = cc; break; case 2: co = -cc; si = -s; break; default: co = s; si = -cc; break; }
        rope[e] = (f32x2){(float)co, (float)si};
    }
    LAS float* scr = (LAS float*)(lds + wave * 8448);
    const int gw = blockIdx.x * 8 + wave, NGW = G * 8;
    constexpr int I_IN = 32 * 96, I_INV = 32 * 32, I_UQ = 8 * 48, I_KVK = 4 * 32, I_KVV = 4 * 32, I_OUT = 32 * 64, I_1 = 32 * 256, I_2 = 128 * 64;
    constexpr int PER_L = I_IN + I_INV + I_UQ + I_KVK + I_KVV + I_OUT + I_1 + I_2;
    for (int it = gw; it < 2 * PER_L; it += NGW) {
        const int l = it / PER_L; int r = it % PER_L;
        if (r < I_1) { transpose_item(A.w_ff1 + (size_t)l * DM * DFF, DM, DFF, (bf16_t*)(ws + WS_W1) + (size_t)l * DFF * DM, 5, nullptr, scr, r, 256, lane); continue; } r -= I_1;
        if (r < I_2) { transpose_item(A.w_ff2 + (size_t)l * DFF * DM, DFF, DM, (bf16_t*)(ws + WS_W2) + (size_t)l * DM * DFF, 5, nullptr, scr, r, 64, lane); continue; } r -= I_2;
        if (r < I_IN) { transpose_item(A.w_in + (size_t)l * DM * INW, DM, INW, (bf16_t*)(ws + WS_WIN) + (size_t)l * 3072 * DM, 0, nullptr, scr, r, 96, lane); continue; } r -= I_IN;
        if (r < I_OUT) { transpose_item(A.w_out + (size_t)l * DM * DM, DM, DM, (bf16_t*)(ws + WS_WOUT) + (size_t)l * DM * DM, 5, nullptr, scr, r, 64, lane); continue; } r -= I_OUT;
        if (r < I_INV) { transpose_item(A.w_in + (size_t)l * DM * INW, DM, INW, (bf16_t*)(ws + WS_WINV) + (size_t)l * 1024 * DM, 1, nullptr, scr, r, 32, lane); continue; } r -= I_INV;
        if (r < I_UQ) { transpose_item(A.w_uq + (size_t)l * 512 * 1536, 512, 1536, (bf16_t*)(ws + WS_WUQ) + (size_t)l * 1536 * 512, 2, A.q_norm + l * 512, scr, r, 48, lane); continue; } r -= I_UQ;
        if (r < I_KVK) { transpose_item(A.w_ukv + (size_t)l * 256 * 2048, 256, 2048, (bf16_t*)(ws + WS_WUKVK) + (size_t)l * 1024 * 256, 3, A.kv_norm + l * 256, scr, r, 32, lane); continue; } r -= I_KVK;
        transpose_item(A.w_ukv + (size_t)l * 256 * 2048, 256, 2048, (bf16_t*)(ws + WS_WUKVV) + (size_t)l * 1024 * 256, 4, A.kv_norm + l * 256, scr, r, 32, lane);
    }
}

__device__ __forceinline__ void norm_mod_phase(const float* __restrict__ X, const float* __restrict__ g, const float* __restrict__ sh, const float* __restrict__ sc, bf16_t* __restrict__ H, int G, const int wv) {
    const int tid = opaque_tid(wv), lane = tid & 63, gw = blockIdx.x * 8 + (tid >> 6), NGW = G * 8;
    for (int row = gw; row < MTOK; row += NGW) {
        const int bb = row >> 11;
        const f32x4* xr = (const f32x4*)(X + (size_t)row * DM) + lane;
        f32x4 v[8]; float ss = 0.f;
#pragma unroll
        for (int j = 0; j < 8; ++j) { v[j] = xr[64 * j]; ss += (v[j][0] * v[j][0] + v[j][1] * v[j][1]) + (v[j][2] * v[j][2] + v[j][3] * v[j][3]); }
        const float rinv = 1.0f / sqrtf(wave_sum(ss, lane) * (1.0f / DM) + EPS);
        u32x2* op = (u32x2*)(H + (size_t)row * DM) + lane;
#pragma unroll
        for (int j = 0; j < 8; ++j) { const int c = (lane + 64 * j) * 4;
            const f32x4 gg = *(const f32x4*)(g + c), s1 = *(const f32x4*)(sc + (size_t)bb * ADAW + c), s0 = *(const f32x4*)(sh + (size_t)bb * ADAW + c);
            const f32x4 y = v[j] * rinv * gg * (s1 + 1.0f) + s0;
            u32x2 w; w.x = cvt_pk_bf16(y[0], y[1]); w.y = cvt_pk_bf16(y[2], y[3]); op[64 * j] = w; }
    }
}
__device__ __forceinline__ void fcumsum_task(const float* __restrict__ LOGF, float* __restrict__ NF2, int bh, int lane) {
    const int bb = bh >> 3, h = bh & 7;
    const float* src = LOGF + ((size_t)bb * SEQ + 32 * lane) * 8 + h;
    float v[32]; float tot = 0.f;
#pragma unroll
    for (int i = 0; i < 32; ++i) { tot += src[(size_t)i * 8]; v[i] = tot; }
    float inc = tot;
#pragma unroll
    for (int o = 1; o < 64; o <<= 1) { const float t = __builtin_bit_cast(float, __builtin_amdgcn_ds_bpermute(((lane - o) & 63) << 2, __builtin_bit_cast(int, inc))); if (lane >= o) inc += t; }
    const float excl = inc - tot;
    float* dst = NF2 + (size_t)bh * SEQ + 32 * lane;
#pragma unroll
    for (int i = 0; i < 32; ++i) dst[i] = -(excl + v[i]) * LOG2E;
}

constexpr int N_PHASES = 17;
__global__ void __launch_bounds__(512) fwd_megakernel(Args A) {
    extern __shared__ __attribute__((aligned(16))) unsigned char lds_raw[];
    LAS unsigned char* lds = (LAS unsigned char*)lds_raw;
    const int G = gridDim.x, bx = blockIdx.x;
    const int wv = __builtin_amdgcn_readfirstlane((int)threadIdx.x >> 6);
    unsigned char* ws = A.ws;
    const int lo = A.ph_lo, hi = A.ph_hi;
#if MK_MULTI
#define SEAM(k) do { } while (0)
#else
    cg::grid_group grid = cg::this_grid();
    unsigned* xbar = (unsigned*)(ws + WS_CTL) + 1024;
    volatile LAS unsigned* xst = (volatile LAS unsigned*)(lds + MISC_OFF + 64);
    { const int t0_ = opaque_tid(wv); if (t0_ == 0) { xst[0] = 0u; xst[1] = 0u; (void)xb_add(&xbar[XB_XCNT(xb_xcc_id())], 1u); } }
#define SEAM(k) do { if (lo <= (k) && (k) + 1 < hi) { if (hi > 1000) grid.sync(); else xcd_barrier(xbar, xst, opaque_tid(wv) == 0); } } while (0)
#endif
#ifndef PHMASK
#define PHMASK 0x3ff
#endif
#define EN(t) ((PHMASK >> (t)) & 1)
#ifndef REPMASK
#define REPMASK 0
#endif
#define NREP(t) (((REPMASK >> (t)) & 1) ? 2 : 1)
#define IN(k) (lo <= (k) && (k) < hi)
    float* mod = (float*)(ws + WS_MOD);
    const f32x2* rope = (const f32x2*)(ws + WS_ROPE);
    bf16_t* Hb = (bf16_t*)(ws + WS_H);
    float* Xb = (float*)(ws + WS_X);

    if (EN(0) && IN(0)) {
        prologue_phase(A, lds, G, wv);
        if (opaque_tid(wv) == 0) { unsigned sp = 0u; while (__hip_atomic_load((unsigned*)(ws + WS_CTL) + 4, __ATOMIC_RELAXED, __HIP_MEMORY_SCOPE_AGENT) < 384u && ++sp < (1u << 22)) __builtin_amdgcn_s_sleep(2); }
        __syncthreads();
        __builtin_amdgcn_fence(__ATOMIC_ACQUIRE, "agent");
        norm_mod_phase(A.x, A.norm_mix, mod, mod + DM, Hb, G, wv);
        SEAM(0);
    }

    for (int l = 0; l < 2; ++l) {
        const int P = 1 + 8 * l;
        const float* modl = mod + (size_t)l * 4 * ADAW;
        const float* Xin = (l == 0) ? A.x : Xb;
        if (EN(2) && IN(P + 1)) {
            {
              pg8::Gemm g{Hb, (const bf16_t*)(ws + WS_WIN) + (size_t)l * 3072 * DM, MTOK, 3072, DM};
              pg8::Gemm g2{(const bf16_t*)(ws + WS_WINV) + (size_t)l * 1024 * DM, Hb, 1024, MTOK, DM};
              pg8::TwoOrders S; S.init(MTOK, 3072, bx, 1024, MTOK, (bx + 128) % G, G);
              EpiInBoth E{EpiIn{(bf16_t*)(ws + WS_CQ), (bf16_t*)(ws + WS_CKV), (bf16_t*)(ws + WS_KR), (bf16_t*)(ws + WS_QK4), (float*)(ws + WS_SSQQ), (float*)(ws + WS_SSQKV), (float*)(ws + WS_LOGF), rope, A.b_forget + l * 8},
                          EpiPlain{(bf16_t*)(ws + WS_VTS), MTOK, 0, 1}};
              pg8::gemm_phase(lds, g, S, E, wv, g2); }
            SEAM(P + 1);
        }
        if (EN(3) && IN(P + 2)) {
            for (int rp_ = 0; rp_ < NREP(3); ++rp_) {
#ifndef P3SEL
#define P3SEL 15
#endif
            if (P3SEL & 1) { const int t_ = opaque_tid(wv); if (bx < 32 && (t_ >> 6) == 0) fcumsum_task((const float*)(ws + WS_LOGF), (float*)(ws + WS_NF2), bx, t_ & 63); }
            if (P3SEL & 2) { pg8::Gemm g{(const bf16_t*)(ws + WS_CQ), (const bf16_t*)(ws + WS_WUQ) + (size_t)l * 1536 * 512, MTOK, 1536, 512}; pg8::StaticOrder S; S.init(MTOK, 1536, G, bx);
              EpiUq E{(bf16_t*)(ws + WS_QM), (const float*)(ws + WS_SSQQ), rope};
              pg8::gemm_phase(lds, g, S, E, wv); }
            if (P3SEL & 4) { pg8::Gemm g{(const bf16_t*)(ws + WS_CKV), (const bf16_t*)(ws + WS_WUKVK) + (size_t)l * 1024 * 256, MTOK, 1024, 256}; pg8::StaticOrder S; S.init(MTOK, 1024, G, (bx + 64) % G);
              EpiKn E{(bf16_t*)(ws + WS_KN), (const float*)(ws + WS_SSQKV)};
              pg8::gemm_phase(lds, g, S, E, wv); }
            if (P3SEL & 8) { const int c2 = (bx >= 192) ? (bx + 64) % G : ((bx >= 64 && bx < 128) ? bx : G - 1);
              pg8::Gemm g{(const bf16_t*)(ws + WS_WUKVV) + (size_t)l * 1024 * 256, (const bf16_t*)(ws + WS_CKV), 1024, MTOK, 256}; pg8::StaticOrder S; S.init(1024, MTOK, G, G == 256 ? c2 : bx);
              EpiVtm E{(bf16_t*)(ws + WS_VTM), (const float*)(ws + WS_SSQKV)};
              pg8::gemm_phase(lds, g, S, E, wv); }
            }
            SEAM(P + 2);
        }
        if (EN(4) && IN(P + 3)) {
            unsigned* ctr = (unsigned*)(ws + WS_CTL) + 64 * l;
            volatile LAS int* qslot = (volatile LAS int*)(lds + MISC_OFF);
            const bf16_t* QK4 = (const bf16_t*)(ws + WS_QK4); const size_t QS = (size_t)MTOK * 512;
            const float* gout = A.out_norm + l * DM;
#ifndef ATT_DYNQ
#define ATT_DYNQ 1
#endif
            for (int ui_ = 0;; ++ui_) {
                int idx;
                if (ATT_DYNQ) {
                    if (ui_ == 0) idx = bx;
                    else {
                        if (opaque_tid(wv) == 0) *qslot = G + (int)atomicAdd(ctr, 1u);
                        __syncthreads();
                        idx = *qslot;
                        __syncthreads();
                    }
                } else {
                    idx = (ui_ == 1) ? (511 - bx) : (ui_ * 256 + bx);
                    if (ui_ >= 3 || G != 256) idx = 768;
                }
                if (idx >= 768) break;
                const int code = att_code(idx >> 5), bh = idx & 31, type = code >> 3, qb = code & 7, bb = bh >> 3, h = bh & 7;
                if (type == 0) attn_unit<0>(bb, h, qb, (const bf16_t*)(ws + WS_QM), (const bf16_t*)(ws + WS_KN), (const bf16_t*)(ws + WS_KR), (const bf16_t*)(ws + WS_VTM), nullptr, gout, (bf16_t*)(ws + WS_OB), lds, wv);
                else if (type == 1) attn_unit<1>(bb, h, qb, QK4, QK4 + QS, nullptr, (const bf16_t*)(ws + WS_VTS), nullptr, gout, (bf16_t*)(ws + WS_OB), lds, wv);
                else attn_unit<2>(bb, h, qb, QK4 + 2 * QS, QK4 + 3 * QS, nullptr, (const bf16_t*)(ws + WS_VTS) + (size_t)512 * MTOK, (const float*)(ws + WS_NF2), gout, (bf16_t*)(ws + WS_OB), lds, wv);
            }
            SEAM(P + 3);
        }
        if (EN(5) && IN(P + 4)) {
            pg8::Gemm g{(const bf16_t*)(ws + WS_OB), (const bf16_t*)(ws + WS_WOUT) + (size_t)l * DM * DM, MTOK, DM, DM}; pg8::StaticOrder S; S.init(MTOK, DM, G, bx);
            EpiResNorm E{Xin, Xb, modl + 2 * DM, A.norm_ffn + l * DM, modl + 3 * DM, modl + 4 * DM, Hb, nullptr, 0,
                         (float*)(ws + WS_XCH) + (size_t)(2 * l) * MTOK * 8, (unsigned*)(ws + WS_CTL) + 8192 + (2 * l) * 2048, (unsigned*)(ws + WS_CTL) + 2};
            pg8::gemm_phase(lds, g, S, E, wv);
            SEAM(P + 4);
        }
        if (EN(7) && IN(P + 6)) {
            pg8::Gemm g{Hb, (const bf16_t*)(ws + WS_W1) + (size_t)l * DFF * DM, MTOK, DFF, DM}; pg8::StaticOrder S; S.init(MTOK, DFF, G, bx);
            EpiPlain E{(bf16_t*)(ws + WS_HB), DFF, 1, 0};
            for (int rp_ = 0; rp_ < NREP(7); ++rp_) pg8::gemm_phase(lds, g, S, E, wv);
            SEAM(P + 6);
        }
        if (EN(8) && IN(P + 7)) {
            pg8::Gemm g{(const bf16_t*)(ws + WS_HB), (const bf16_t*)(ws + WS_W2) + (size_t)l * DM * DFF, MTOK, DM, DFF}; pg8::StaticOrder S; S.init(MTOK, DM, G, bx);
            const float* mod1 = mod + (size_t)4 * ADAW;
            EpiResNorm E{Xb, (l == 0) ? Xb : nullptr, modl + 5 * DM, (l == 0) ? A.norm_mix + DM : A.final_norm, mod1 + 0 * DM, mod1 + 1 * DM, Hb, A.out, (l == 0) ? 0 : 1,
                         (float*)(ws + WS_XCH) + (size_t)(2 * l + 1) * MTOK * 8, (unsigned*)(ws + WS_CTL) + 8192 + (2 * l + 1) * 2048, (unsigned*)(ws + WS_CTL) + 2};
            pg8::gemm_phase(lds, g, S, E, wv);
            SEAM(P + 7);
        }
    }
#undef IN
#undef SEAM
}

extern "C" void kernel_launch(void* const* d_in, const int* in_sizes, int n_in, void* d_out, int out_size, void* d_ws, size_t ws_size, hipStream_t stream) {
    static int grid = 0;
    if (grid == 0) {
        if (n_in != 17 || out_size != MTOK * DM || ws_size < WS_END) { fprintf(stderr, "kernel_launch: unexpected problem (n_in %d out %d ws %zu)\n", n_in, out_size, ws_size); grid = -1; return; }
        int dev = 0, cus = 0, per_cu = 0;
        hipGetDevice(&dev);
        hipDeviceGetAttribute(&cus, hipDeviceAttributeMultiprocessorCount, dev);
        if (hipFuncSetAttribute((const void*)fwd_megakernel, hipFuncAttributeMaxDynamicSharedMemorySize, LDS_BYTES) != hipSuccess) { fprintf(stderr, "kernel_launch: hipFuncSetAttribute failed\n"); grid = -1; return; }
        if (hipOccupancyMaxActiveBlocksPerMultiprocessor(&per_cu, (const void*)fwd_megakernel, 512, LDS_BYTES) != hipSuccess || per_cu < 1) { fprintf(stderr, "kernel_launch: occupancy query says %d\n", per_cu); per_cu = 1; }
        (void)hipGetLastError();
        grid = cus * (per_cu < 1 ? 1 : 1);
        if (grid <= 0) grid = 256;
    }
    if (grid < 0) return;
    hipMemsetAsync((char*)d_ws + WS_CTL, 0, CTL_BYTES, stream);
    Args a{};
    a.x = (const float*)d_in[0]; a.c = (const float*)d_in[1]; a.w_ada = (const float*)d_in[2]; a.b_ada = (const float*)d_in[3]; a.norm_mix = (const float*)d_in[4];
    a.w_in = (const float*)d_in[5]; a.q_norm = (const float*)d_in[6]; a.w_uq = (const float*)d_in[7]; a.kv_norm = (const float*)d_in[8]; a.w_ukv = (const float*)d_in[9];
    a.b_forget = (const float*)d_in[10]; a.out_norm = (const float*)d_in[11]; a.w_out = (const float*)d_in[12]; a.norm_ffn = (const float*)d_in[13];
    a.w_ff1 = (const float*)d_in[14]; a.w_ff2 = (const float*)d_in[15]; a.final_norm = (const float*)d_in[16];
    a.out = (float*)d_out; a.ws = (unsigned char*)d_ws;
#if MK_MULTI
    for (int p = 0; p < N_PHASES; ++p) { a.ph_lo = p; a.ph_hi = p + 1; hipLaunchKernelGGL(fwd_megakernel, dim3(grid), dim3(512), LDS_BYTES, stream, a); }
#else
    a.ph_lo = 0; a.ph_hi = N_PHASES;
    void* args[] = {&a};
    hipError_t e = hipLaunchCooperativeKernel((const void*)fwd_megakernel, dim3(grid), dim3(512), args, LDS_BYTES, stream);
    if (e != hipSuccess) fprintf(stderr, "kernel_launch: cooperative launch failed: %s (grid %d)\n", hipGetErrorString(e), grid);
#endif
}
```
